# Optimizing an MI355X kernel written in HIP

```python
import jax, jax.numpy as jnp
from jax import lax
import numpy as np

D_MODEL = 1024
BATCH = 4
SEQ = 4096
DEPTH = 1
DEC_BATCH = 16
DEC_SEQ = 32
PAST_LEN = 4096

CHUNK = 64
GLA_HEADS = 4
GLA_DK = 128
GLA_DV = 256
GLA_KEY = GLA_HEADS * GLA_DK
GLA_VAL = GLA_HEADS * GLA_DV
GLA_RANK = 16
GLA_TAU = 16.0
CONV_DIM = D_MODEL
CONV_W = 3
D_FF = -(-8 * D_MODEL // (3 * 256)) * 256
N_MOD = 6
EPS = 1e-6
IN_SIZES = (GLA_KEY, GLA_KEY, GLA_VAL, GLA_VAL, GLA_RANK, CONV_DIM, CONV_DIM, CONV_DIM, D_MODEL, D_MODEL)
IN_DIM = sum(IN_SIZES)

kernel_name = 'streaming_gla_shortconv_hybrid'


def rmsnorm(x, g):
    xf = x.astype(jnp.float32)
    xf = xf * lax.rsqrt(jnp.mean(xf * xf, axis=-1, keepdims=True) + EPS)
    return (xf * g.astype(jnp.float32)).astype(x.dtype)


def gla_recurrence(q, k, v, la, S0):
    Bn, L = q.shape[0], q.shape[1]
    blk = min(CHUNK, L)
    n = L // blk

    def to_blocks(t):
        return jnp.moveaxis(t.reshape((Bn, n, blk) + t.shape[2:]), 1, 0)

    mask = jnp.tril(jnp.ones((blk, blk), bool))[None, :, :, None, None]

    def step(S, inp):
        qb, kb, vb, lb = inp
        bcum = jnp.cumsum(lb, axis=1)
        diff = bcum[:, :, None] - bcum[:, None]
        decay = jnp.exp(jnp.where(mask, diff, -jnp.inf))
        scores = jnp.einsum('bihd,bjhd,bijhd->bhij', qb, kb, decay)
        o = (jnp.einsum('bhij,bjhv->bihv', scores, vb)
             + jnp.einsum('bihd,bhdv->bihv', qb * jnp.exp(bcum), S))
        blast = bcum[:, -1]
        S = (jnp.exp(blast)[..., None] * S
             + jnp.einsum('bjhd,bjhv->bhdv', kb * jnp.exp(blast[:, None] - bcum), vb))
        return S, o

    S, o = lax.scan(step, S0, (to_blocks(q), to_blocks(k), to_blocks(v), to_blocks(la)))
    o = jnp.moveaxis(o, 0, 1).reshape(Bn, L, GLA_HEADS, GLA_DV)
    return S, o


def causal_conv(u, prev, conv_w, conv_b):
    L = u.shape[1]
    up = jnp.concatenate([prev.astype(u.dtype), u], axis=1)
    y = up[:, 0:L] * conv_w[0] + up[:, 1:L + 1] * conv_w[1] + up[:, 2:L + 2] * conv_w[2] + conv_b
    return y, up[:, L:]


def token_mixer(h, S0, conv_prev, w_in, w_alpha, b_alpha, gla_norm_g, w_gla_out, conv_w, conv_b, w_conv_out, w_o):
    Bn, L, _ = h.shape
    z = h @ w_in
    q, k, v, g, a, cb, cc, ch, ga, gb = jnp.split(z, list(np.cumsum(IN_SIZES)[:-1]), axis=-1)
    q = q.reshape(Bn, L, GLA_HEADS, GLA_DK).astype(jnp.float32) * (GLA_DK ** -0.5)
    k = k.reshape(Bn, L, GLA_HEADS, GLA_DK).astype(jnp.float32)
    v = v.reshape(Bn, L, GLA_HEADS, GLA_DV).astype(jnp.float32)
    la = jax.nn.log_sigmoid((a @ w_alpha + b_alpha).astype(jnp.float32)) / GLA_TAU
    la = la.reshape(Bn, L, GLA_HEADS, GLA_DK)
    S_new, o = gla_recurrence(q, k, v, la, S0.astype(jnp.float32))
    o = o * lax.rsqrt(jnp.mean(o * o, axis=-1, keepdims=True) + EPS) * gla_norm_g.astype(jnp.float32)
    o = o.reshape(Bn, L, GLA_VAL).astype(h.dtype) * jax.nn.silu(g)
    y_a = o @ w_gla_out
    conv, new_buf = causal_conv(cc * ch, conv_prev, conv_w, conv_b)
    y_b = (cb * conv) @ w_conv_out
    merged = jax.nn.sigmoid(ga) * y_a + jax.nn.sigmoid(gb) * y_b
    return merged @ w_o, S_new, new_buf


def layer(x, c, S0, conv_prev, p):
    (w_mod, b_mod, norm1_g, w_in, w_alpha, b_alpha, gla_norm_g, w_gla_out,
     conv_w, conv_b, w_conv_out, w_o, norm2_g, w_ffn_in, w_ffn_out) = p
    mod = (c @ w_mod + b_mod)[:, None, :]
    sh1, sc1, g1, sh2, sc2, g2 = jnp.split(mod, N_MOD, axis=-1)
    h = rmsnorm(x, norm1_g) * (1 + sc1) + sh1
    m, S_new, buf = token_mixer(h, S0, conv_prev, w_in, w_alpha, b_alpha, gla_norm_g, w_gla_out,
                                conv_w, conv_b, w_conv_out, w_o)
    x = x + g1 * m
    h = rmsnorm(x, norm2_g) * (1 + sc2) + sh2
    gt, upv = jnp.split(h @ w_ffn_in, 2, axis=-1)
    x = x + g2 * ((jax.nn.silu(gt) * upv) @ w_ffn_out)
    return x, S_new, buf


def setup_inputs(seed: int = 0) -> dict:
    key = jax.random.key(seed)
    ks = jax.random.split(key, 24)
    f32 = jnp.float32
    D = D_MODEL

    def nrm(k, shape, scale):
        return jax.random.normal(k, shape, f32) * scale

    return {
        'x_prompt': nrm(ks[0], (BATCH, SEQ, D), 1.0),
        'x_sample': nrm(ks[1], (DEC_BATCH, DEC_SEQ, D), 1.0),
        'c_prompt': nrm(ks[2], (BATCH, D), 1.0),
        'c_sample': nrm(ks[3], (DEC_BATCH, D), 1.0),
        'state_gla': nrm(ks[4], (DEPTH, DEC_BATCH, GLA_HEADS, GLA_DK, GLA_DV), 0.5),
        'cache_conv': nrm(ks[5], (DEPTH, DEC_BATCH, CONV_W - 1, CONV_DIM), 1.0),
        'w_mod': nrm(ks[6], (DEPTH, D, N_MOD * D), 0.5 * D ** -0.5),
        'b_mod': nrm(ks[7], (DEPTH, N_MOD * D), 0.02),
        'norm1_g': 1.0 + nrm(ks[8], (DEPTH, D), 0.02),
        'w_in': nrm(ks[9], (DEPTH, D, IN_DIM), D ** -0.5),
        'w_alpha': nrm(ks[10], (DEPTH, GLA_RANK, GLA_KEY), GLA_RANK ** -0.5),
        'b_alpha': nrm(ks[11], (DEPTH, GLA_KEY), 0.02),
        'gla_norm_g': 1.0 + nrm(ks[12], (DEPTH, GLA_DV), 0.02),
        'w_gla_out': nrm(ks[13], (DEPTH, GLA_VAL, D), GLA_VAL ** -0.5),
        'conv_w': nrm(ks[14], (DEPTH, CONV_W, CONV_DIM), CONV_W ** -0.5),
        'conv_b': nrm(ks[15], (DEPTH, CONV_DIM), 0.02),
        'w_conv_out': nrm(ks[16], (DEPTH, CONV_DIM, D), CONV_DIM ** -0.5),
        'w_o': nrm(ks[17], (DEPTH, D, D), D ** -0.5),
        'norm2_g': 1.0 + nrm(ks[18], (DEPTH, D), 0.02),
        'w_ffn_in': nrm(ks[19], (DEPTH, D, 2 * D_FF), D ** -0.5),
        'w_ffn_out': nrm(ks[20], (DEPTH, D_FF, D), D_FF ** -0.5),
        'norm_f_g': 1.0 + nrm(ks[21], (D,), 0.02),
    }


def reference(x_prompt, x_sample, c_prompt, c_sample, state_gla, cache_conv, w_mod, b_mod, norm1_g,
              w_in, w_alpha, b_alpha, gla_norm_g, w_gla_out, conv_w, conv_b, w_conv_out, w_o,
              norm2_g, w_ffn_in, w_ffn_out, norm_f_g):
    Bp = x_prompt.shape[0]
    yp, ys = x_prompt, x_sample
    sp_list, cp_list, ss_list, cs_list = [], [], [], []
    for l in range(DEPTH):
        p = (w_mod[l], b_mod[l], norm1_g[l], w_in[l], w_alpha[l], b_alpha[l], gla_norm_g[l],
             w_gla_out[l], conv_w[l], conv_b[l], w_conv_out[l], w_o[l], norm2_g[l],
             w_ffn_in[l], w_ffn_out[l])
        S0_p = jnp.zeros((Bp, GLA_HEADS, GLA_DK, GLA_DV), jnp.float32)
        buf0_p = jnp.zeros((Bp, CONV_W - 1, CONV_DIM), x_prompt.dtype)
        yp, sp, cp = layer(yp, c_prompt, S0_p, buf0_p, p)
        ys, ss, cs = layer(ys, c_sample, state_gla[l], cache_conv[l], p)
        sp_list.append(sp)
        cp_list.append(cp)
        ss_list.append(ss)
        cs_list.append(cs)
    y_prompt = rmsnorm(yp, norm_f_g)
    y_sample = rmsnorm(ys, norm_f_g)
    state_gla_p = jnp.stack(sp_list)
    cache_conv_p = jnp.stack(cp_list)
    state_gla_s = jnp.stack(ss_list)
    cache_conv_s = jnp.stack(cs_list)
    return (y_prompt, y_sample, state_gla_p, cache_conv_p, state_gla_s, cache_conv_s)
```

```cpp
#include <hip/hip_runtime.h>
#include <hip/hip_cooperative_groups.h>
#include <cstdio>
#include <cstdint>
namespace cg = cooperative_groups;

#define LAS __attribute__((address_space(3)))
typedef unsigned short bf16_t;
typedef short bf16x8 __attribute__((ext_vector_type(8)));
typedef float f32x4 __attribute__((ext_vector_type(4)));
typedef float f32x16 __attribute__((ext_vector_type(16)));
typedef unsigned u32x4 __attribute__((ext_vector_type(4)));
typedef unsigned u32x2 __attribute__((ext_vector_type(2)));

constexpr int DM = 1024, MP = 16384, MTOT = 16896, NMODROW = 20, NMOD = 6144;
constexpr int NIN = 8448;
constexpr int DFF = 2816;
constexpr int NSEG = 16, SEGCH = 4;
constexpr float EPS = 1e-6f;

constexpr size_t WS_WIN = 0;
constexpr size_t WS_WGC = WS_WIN + (size_t)NIN * 1024 * 2;
constexpr size_t WS_WO  = WS_WGC + (size_t)2 * 1024 * 1024 * 2;
constexpr size_t WS_WF1 = WS_WO + (size_t)1024 * 1024 * 2;
constexpr size_t WS_WF2 = WS_WF1 + (size_t)5632 * 1024 * 2;
constexpr size_t WS_MOD = WS_WF2 + (size_t)1024 * 2816 * 2;
constexpr size_t WS_H   = WS_MOD + (size_t)NMODROW * NMOD * 4;
constexpr size_t WS_Z   = WS_H + (size_t)MTOT * 1024 * 2;
constexpr size_t Z_Q = WS_Z;
constexpr size_t Z_K = Z_Q + (size_t)MTOT * 512 * 2;
constexpr size_t Z_V = Z_K + (size_t)MTOT * 512 * 2;
constexpr size_t Z_G = Z_V + (size_t)MTOT * 1024 * 2;
constexpr size_t Z_CB = Z_G + (size_t)MTOT * 1024 * 2;
constexpr size_t Z_P = Z_CB + (size_t)MTOT * 1024 * 2;
constexpr size_t Z_A = Z_P + (size_t)MTOT * 1024 * 2;
constexpr size_t WS_END = Z_A + (size_t)MTOT * 256 * 2;
constexpr size_t SEG_STATE = WS_H;
constexpr size_t SEG_DEC = WS_H + (size_t)16 * 16 * 32768 * 4;
static_assert(SEG_DEC + 16 * 16 * 128 * 4 <= WS_Z, "seg state fits in H");
static_assert(WS_END <= (size_t)256 * 1024 * 1024, "ws");
constexpr size_t O_Y = 0, O_SP = 17301504, O_CP = 17825792, O_SS = 17833984, O_CS = 19931136;

constexpr int LDS_BYTES = 144 * 1024;

struct Params { const float* in[22]; float* out; unsigned char* ws; };

__device__ __forceinline__ unsigned cvt_pk_bf16(float lo, float hi) { unsigned r; asm("v_cvt_pk_bf16_f32 %0, %1, %2" : "=v"(r) : "v"(lo), "v"(hi)); return r; }
__device__ __forceinline__ float bf_lo(unsigned w) { return __uint_as_float(w << 16); }
__device__ __forceinline__ float bf_hi(unsigned w) { return __uint_as_float(w & 0xffff0000u); }
__device__ __forceinline__ float bf2f(bf16_t b) { return __uint_as_float(((unsigned)b) << 16); }
__device__ __forceinline__ bf16_t f2bf(float f) { return (bf16_t)(cvt_pk_bf16(f, 0.f) & 0xffffu); }
__device__ __forceinline__ float sigmoidf_(float x) { return 1.0f / (1.0f + __expf(-x)); }
__device__ __forceinline__ int modrow_of(int row) { return row < MP ? (row >> 12) : 4 + ((row - MP) >> 5); }

namespace pg8 {
constexpr int BM = 256, BK = 64, HALF = 128, HTB = HALF * BK * 2, STAGE_BYTES = 8 * HTB, NXCD = 8, WGM = 8;
__host__ __device__ __forceinline__ int lds_byte(int r, int c) { const int st = (r >> 4) * 2 + (c >> 5), rr = r & 15, cc = c & 31, ob = rr * 64 + cc * 2; return st * 1024 + (ob ^ (((ob >> 9) & 1) << 5)); }
__host__ __device__ __forceinline__ void stage_rc(int b, int& R, int& C) { const int st = b / 1024, sb = b % 1024, swz = sb ^ (((sb >> 9) & 1) << 5); R = (st >> 1) * 16 + swz / 64; C = (st & 1) * 32 + (swz % 64) / 2; }
__host__ __device__ __forceinline__ int perm32(int rho) { const int n = rho >> 4, i = rho & 15; return 8 * (i >> 2) + 4 * n + (i & 3); }

struct Unit { int pm, pn; };
struct Gemm { const bf16_t* A; const bf16_t* Bt; int K; };

struct Order {
    int nM, nN, nwg, G, c, paired, dpm, dpn;
    __device__ void init(int nM_, int nN_, int G_, int c_, int paired_ = 0, int dpm_ = 0, int dpn_ = 0) { nM = nM_; nN = nN_; nwg = nM * nN; G = G_; c = c_; paired = paired_; dpm = dpm_; dpn = dpn_; }
    __device__ bool next(int i, Unit& u) const {
        const int it = paired ? (i >> 1) : i;
        const long L = (long)it * G + c; if (L >= nwg) return false;
        int wgid = (int)L; { const int q = nwg / NXCD, r = nwg % NXCD, xcd = wgid % NXCD, off = wgid / NXCD; wgid = (xcd < r ? xcd * (q + 1) : r * (q + 1) + (xcd - r) * q) + off; }
        const int nig = WGM * nN, gid = wgid / nig, fm = gid * WGM, gsz = (nM - fm) < WGM ? (nM - fm) : WGM;
        u.pm = fm + ((wgid % nig) % gsz); u.pn = (wgid % nig) / gsz;
        if (paired && (i & 1)) { u.pm += dpm; u.pn += dpn; }
        return true;
    }
};

template <class Epi>
__device__ __forceinline__ void gemm_phase(LAS unsigned char* lds, const Gemm g, const Order& S, const Epi& E) {
    const int tid = threadIdx.x, wid = __builtin_amdgcn_readfirstlane(tid >> 6), lane = tid & 63, wr = wid >> 2, wc = wid & 3, fr = lane & 15, fq = lane >> 4;
    const int K = g.K, nt = K / BK;
    unsigned voffA[2], voffB[2];
#pragma unroll
    for (int i = 0; i < 2; ++i) { int R, C; stage_rc(tid * 16 + i * 8192, R, C); const int Rb = Epi::PERM ? ((R & ~31) + perm32(R & 31)) : R;
        voffA[i] = (unsigned)(R * K + C) * 2u; voffB[i] = (unsigned)(Rb * K + C) * 2u; }
    const size_t kstep = (size_t)(BK * 2);
    const size_t hstep = (size_t)HALF * K * 2;
    const size_t tstep = 2 * hstep;
    const unsigned ldsw = (unsigned)wid * 1024u;
    const int aoff = lds_byte(wr * 64 + fr, fq * 8), boff = lds_byte(wc * 32 + fr, fq * 8);
#define PG8_SA(b, h) (((b) * 2 + (h)) * HTB)
#define PG8_SB(b, h) ((4 + (b) * 2 + (h)) * HTB)
#define PG8_STAGE(bufoff, gbase, voff) do { _Pragma("unroll") for (int _i = 0; _i < 2; ++_i) \
        __builtin_amdgcn_global_load_lds((const unsigned*)((const char*)(gbase) + (voff)[_i]), (LAS unsigned*)(lds + (bufoff) + ldsw + _i * 8192), 16, 0, 0); } while (0)
#define PG8_LDA(dst, b, h) do { _Pragma("unroll") for (int m = 0; m < 4; ++m) _Pragma("unroll") for (int k = 0; k < 2; ++k) dst[m][k] = *(const LAS bf16x8*)(lds + PG8_SA(b, h) + aoff + m * 2048 + k * 1024); } while (0)
#define PG8_LDB(dst, b, h) do { _Pragma("unroll") for (int n = 0; n < 2; ++n) _Pragma("unroll") for (int k = 0; k < 2; ++k) dst[n][k] = *(const LAS bf16x8*)(lds + PG8_SB(b, h) + boff + n * 2048 + k * 1024); } while (0)
#define PG8_MMA(ai, bj, At, Bt) do { __builtin_amdgcn_s_setprio(1); _Pragma("unroll") for (int m = 0; m < 4; ++m) _Pragma("unroll") for (int n = 0; n < 2; ++n) _Pragma("unroll") for (int k = 0; k < 2; ++k) \
        acc[ai][bj][m][n] = __builtin_amdgcn_mfma_f32_16x16x32_bf16(Bt[n][k], At[m][k], acc[ai][bj][m][n], 0, 0, 0); __builtin_amdgcn_s_setprio(0); } while (0)
#define PG8_WAIT_V(n) asm volatile("s_waitcnt vmcnt(" #n ")" ::: "memory")
#define PG8_WAIT_L(n) asm volatile("s_waitcnt lgkmcnt(" #n ")" ::: "memory")
#define PG8_BAR __builtin_amdgcn_s_barrier()
#define PG8_SCHED __builtin_amdgcn_sched_barrier(0)
    Unit cur, nxt; int ui = 0;
    if (!S.next(0, cur)) return;
    f32x4 acc[2][2][4][2];
#pragma unroll
    for (int a = 0; a < 2; ++a)
#pragma unroll
        for (int b = 0; b < 2; ++b)
#pragma unroll
            for (int m = 0; m < 4; ++m)
#pragma unroll
                for (int n = 0; n < 2; ++n) acc[a][b][m][n] = (f32x4){0.f, 0.f, 0.f, 0.f};
    bf16x8 At[4][2], B0[2][2], B1[2][2];
    const char* cA = (const char*)g.A + (size_t)cur.pm * tstep; const char* cB = (const char*)g.Bt + (size_t)cur.pn * tstep;
    PG8_STAGE(PG8_SB(0, 0), cB, voffB); PG8_STAGE(PG8_SB(0, 1), cB + hstep, voffB); PG8_STAGE(PG8_SA(0, 0), cA, voffA); PG8_STAGE(PG8_SA(0, 1), cA + hstep, voffA);
    if (wr == 1) PG8_BAR;
    PG8_WAIT_V(2); PG8_BAR;
    PG8_STAGE(PG8_SB(1, 0), cB + kstep, voffB); PG8_STAGE(PG8_SA(1, 0), cA + kstep, voffA); PG8_STAGE(PG8_SB(1, 1), cB + hstep + kstep, voffB);
    PG8_WAIT_V(6); PG8_BAR;
    for (;;) {
        const bool has_next = S.next(ui + 1, nxt);
        const char* nA = has_next ? (const char*)g.A + (size_t)nxt.pm * tstep : cA; const char* nB = has_next ? (const char*)g.Bt + (size_t)nxt.pn * tstep : cB;
        for (int t = 0; t < nt; t += 2) {
            const bool last = (t == nt - 2);
            const char* a1 = cA + (size_t)(t + 1) * kstep;
            const char* a2 = last ? nA : cA + (size_t)(t + 2) * kstep; const char* b2 = last ? nB : cB + (size_t)(t + 2) * kstep;
            const char* a3 = a2 + kstep; const char* b3 = b2 + kstep;
            PG8_LDB(B0, 0, 0); PG8_LDB(B1, 0, 1); PG8_SCHED; PG8_LDA(At, 0, 0); PG8_STAGE(PG8_SA(1, 1), a1 + hstep, voffA);
            PG8_WAIT_V(8); PG8_WAIT_L(0); PG8_BAR; PG8_MMA(0, 0, At, B0); PG8_MMA(0, 1, At, B1); PG8_BAR; PG8_SCHED;
            PG8_LDA(At, 0, 1); PG8_STAGE(PG8_SB(0, 0), b2, voffB); PG8_STAGE(PG8_SB(0, 1), b2 + hstep, voffB); PG8_STAGE(PG8_SA(0, 0), a2, voffA);
            PG8_WAIT_V(8); PG8_WAIT_L(0); PG8_BAR; PG8_MMA(1, 0, At, B0); PG8_MMA(1, 1, At, B1); PG8_BAR; PG8_SCHED;
            PG8_LDB(B0, 1, 0); PG8_LDB(B1, 1, 1); PG8_SCHED; PG8_LDA(At, 1, 0); PG8_STAGE(PG8_SA(0, 1), a2 + hstep, voffA);
            PG8_WAIT_V(8); PG8_WAIT_L(0); PG8_BAR; PG8_MMA(0, 0, At, B0); PG8_MMA(0, 1, At, B1); PG8_BAR; PG8_SCHED;
            PG8_LDA(At, 1, 1); PG8_STAGE(PG8_SB(1, 0), b3, voffB); PG8_STAGE(PG8_SB(1, 1), b3 + hstep, voffB); PG8_STAGE(PG8_SA(1, 0), a3, voffA);
            PG8_WAIT_V(8); PG8_WAIT_L(0); PG8_BAR; PG8_MMA(1, 0, At, B0); PG8_MMA(1, 1, At, B1); PG8_BAR; PG8_SCHED;
        }
        if (wr == 0) PG8_BAR;
        E(acc, cur, ui, wr, wc, fr, fq);
        if (!has_next) break;
        if (!(Epi::PAIRED && (ui & 1) == 0)) {
#pragma unroll
            for (int a = 0; a < 2; ++a)
#pragma unroll
                for (int b = 0; b < 2; ++b)
#pragma unroll
                    for (int m = 0; m < 4; ++m)
#pragma unroll
                        for (int n = 0; n < 2; ++n) acc[a][b][m][n] = (f32x4){0.f, 0.f, 0.f, 0.f};
        }
        cur = nxt; cA = nA; cB = nB; ++ui;
        if (wr == 1) PG8_BAR;
    }
    PG8_WAIT_V(0);
    PG8_BAR;
#undef PG8_SA
#undef PG8_SB
#undef PG8_STAGE
#undef PG8_LDA
#undef PG8_LDB
#undef PG8_MMA
#undef PG8_WAIT_V
#undef PG8_WAIT_L
#undef PG8_BAR
#undef PG8_SCHED
}
}

typedef f32x4 acc_t[2][2][4][2];

struct EpiIn {
    static constexpr bool PERM = true, PAIRED = false;
    unsigned char* ws; bf16_t* Rg; bf16_t* Gg;
    __device__ __forceinline__ void operator()(acc_t& acc, const pg8::Unit& u, int ui, int wr, int wc, int fr, int fq) const {
        const int row0 = u.pm * 256 + wr * 64 + fr; const int pn = u.pn;
        if (pn < 16 || pn == 24) {
            bf16_t* base; int ldc, colt;
            if (pn < 2) { base = (bf16_t*)(ws + Z_Q); ldc = 512; colt = pn * 256; }
            else if (pn < 4) { base = (bf16_t*)(ws + Z_K); ldc = 512; colt = (pn - 2) * 256; }
            else if (pn < 8) { base = (bf16_t*)(ws + Z_V); ldc = 1024; colt = (pn - 4) * 256; }
            else if (pn < 12) { base = (bf16_t*)(ws + Z_G); ldc = 1024; colt = (pn - 8) * 256; }
            else if (pn < 16) { base = (bf16_t*)(ws + Z_CB); ldc = 1024; colt = (pn - 12) * 256; }
            else { base = (bf16_t*)(ws + Z_A); ldc = 256; colt = 0; }
            const int col0 = colt + wc * 32 + 8 * fq;
#pragma unroll
            for (int ai = 0; ai < 2; ++ai)
#pragma unroll
                for (int m = 0; m < 4; ++m) { bf16_t* rowp = base + (size_t)(row0 + ai * 128 + m * 16) * ldc + col0;
#pragma unroll
                    for (int bj = 0; bj < 2; ++bj) { const f32x4 v0 = acc[ai][bj][m][0], v1 = acc[ai][bj][m][1];
                        u32x4 w; w.x = cvt_pk_bf16(v0[0], v0[1]); w.y = cvt_pk_bf16(v0[2], v0[3]); w.z = cvt_pk_bf16(v1[0], v1[1]); w.w = cvt_pk_bf16(v1[2], v1[3]);
                        *(u32x4*)(rowp + bj * 128) = w; } }
        } else if (pn < 24) {
            bf16_t* base = (bf16_t*)(ws + Z_P); const int ch0 = (pn - 16) * 128 + wc * 16 + 4 * fq;
#pragma unroll
            for (int ai = 0; ai < 2; ++ai)
#pragma unroll
                for (int m = 0; m < 4; ++m) { bf16_t* rowp = base + (size_t)(row0 + ai * 128 + m * 16) * 1024 + ch0;
#pragma unroll
                    for (int bj = 0; bj < 2; ++bj) { const f32x4 p = acc[ai][bj][m][0] * acc[ai][bj][m][1];
                        u32x2 w; w.x = cvt_pk_bf16(p[0], p[1]); w.y = cvt_pk_bf16(p[2], p[3]); *(u32x2*)(rowp + bj * 64) = w; } }
        } else {
            const int ch0 = (pn - 25) * 128 + wc * 16 + 4 * fq;
#pragma unroll
            for (int ai = 0; ai < 2; ++ai)
#pragma unroll
                for (int m = 0; m < 4; ++m) { const size_t ro = (size_t)(row0 + ai * 128 + m * 16) * 1024 + ch0;
#pragma unroll
                    for (int bj = 0; bj < 2; ++bj) { const f32x4 ga = acc[ai][bj][m][0], gb = acc[ai][bj][m][1]; float r[4], s[4];
#pragma unroll
                        for (int j = 0; j < 4; ++j) { const float ea = __expf(-ga[j]), eb = __expf(-gb[j]); s[j] = 1.0f / (1.0f + eb); r[j] = (1.0f + eb) / (1.0f + ea); }
                        u32x2 w; w.x = cvt_pk_bf16(r[0], r[1]); w.y = cvt_pk_bf16(r[2], r[3]); *(u32x2*)(Rg + ro + bj * 64) = w;
                        u32x2 x; x.x = cvt_pk_bf16(s[0], s[1]); x.y = cvt_pk_bf16(s[2], s[3]); *(u32x2*)(Gg + ro + bj * 64) = x; } }
        }
    }
};

struct EpiMerge {
    static constexpr bool PERM = true, PAIRED = true;
    const bf16_t* Rg; const bf16_t* Gg; bf16_t* O;
    __device__ __forceinline__ void operator()(acc_t& acc, const pg8::Unit& u, int ui, int wr, int wc, int fr, int fq) const {
        const int second = ui & 1; const int pm = second ? u.pm - 66 : u.pm, pn = second ? u.pn - 4 : u.pn;
        const int row0 = pm * 256 + wr * 64 + fr, col0 = pn * 256 + wc * 32 + 8 * fq;
        const bf16_t* src = second ? Gg : Rg;
#pragma unroll
        for (int ai = 0; ai < 2; ++ai)
#pragma unroll
            for (int m = 0; m < 4; ++m) { const size_t ro = (size_t)(row0 + ai * 128 + m * 16) * 1024 + col0;
#pragma unroll
                for (int bj = 0; bj < 2; ++bj) { const u32x4 f = *(const u32x4*)(src + ro + bj * 128);
                    f32x4 v0 = acc[ai][bj][m][0], v1 = acc[ai][bj][m][1];
                    v0[0] *= bf_lo(f.x); v0[1] *= bf_hi(f.x); v0[2] *= bf_lo(f.y); v0[3] *= bf_hi(f.y);
                    v1[0] *= bf_lo(f.z); v1[1] *= bf_hi(f.z); v1[2] *= bf_lo(f.w); v1[3] *= bf_hi(f.w);
                    if (second) { u32x4 w; w.x = cvt_pk_bf16(v0[0], v0[1]); w.y = cvt_pk_bf16(v0[2], v0[3]); w.z = cvt_pk_bf16(v1[0], v1[1]); w.w = cvt_pk_bf16(v1[2], v1[3]);
                        *(u32x4*)(O + ro + bj * 128) = w; }
                    else { acc[ai][bj][m][0] = v0; acc[ai][bj][m][1] = v1; } } }
    }
};

struct EpiRes {
    static constexpr bool PERM = false, PAIRED = false;
    const float* base0; const float* base1;
    float* out; const float* gate;
    __device__ __forceinline__ void operator()(acc_t& acc, const pg8::Unit& u, int ui, int wr, int wc, int fr, int fq) const {
        const int row0 = u.pm * 256 + wr * 64 + fr, col0 = u.pn * 256 + wc * 32 + 4 * fq;
#pragma unroll
        for (int ai = 0; ai < 2; ++ai)
#pragma unroll
            for (int m = 0; m < 4; ++m) { const int row = row0 + ai * 128 + m * 16;
                const float* bp = (row < MP ? base0 + (size_t)row * 1024 : base1 + (size_t)(row - MP) * 1024) + col0;
                const float* gp = gate + (size_t)modrow_of(row) * NMOD + col0; float* op = out + (size_t)row * 1024 + col0;
#pragma unroll
                for (int bj = 0; bj < 2; ++bj)
#pragma unroll
                    for (int n = 0; n < 2; ++n) { const f32x4 b = *(const f32x4*)(bp + bj * 128 + n * 16), gt = *(const f32x4*)(gp + bj * 128 + n * 16);
                        *(f32x4*)(op + bj * 128 + n * 16) = b + gt * acc[ai][bj][m][n]; }
                asm volatile("" ::: "memory"); }
    }
};

struct EpiAct {
    static constexpr bool PERM = true, PAIRED = false;
    bf16_t* O;
    __device__ __forceinline__ void operator()(acc_t& acc, const pg8::Unit& u, int ui, int wr, int wc, int fr, int fq) const {
        const int row0 = u.pm * 256 + wr * 64 + fr, ch0 = u.pn * 128 + wc * 16 + 4 * fq;
#pragma unroll
        for (int ai = 0; ai < 2; ++ai)
#pragma unroll
            for (int m = 0; m < 4; ++m) { bf16_t* rowp = O + (size_t)(row0 + ai * 128 + m * 16) * DFF + ch0;
#pragma unroll
                for (int bj = 0; bj < 2; ++bj) { const f32x4 gt = acc[ai][bj][m][0], up = acc[ai][bj][m][1]; float a[4];
#pragma unroll
                    for (int j = 0; j < 4; ++j) a[j] = gt[j] * up[j] / (1.0f + __expf(-gt[j]));
                    u32x2 w; w.x = cvt_pk_bf16(a[0], a[1]); w.y = cvt_pk_bf16(a[2], a[3]); *(u32x2*)(rowp + bj * 64) = w; } }
    }
};

__device__ __forceinline__ int pairrow(int idx, int n) { const int tp = idx >> 7, w = idx & 127; return 256 * tp + 32 * (w >> 4) + 8 * ((w >> 2) & 3) + 4 * n + (w & 3); }
__device__ __forceinline__ int map_win(int c) {
    if (c < 3072) return c;
    if (c < 3088) return 6144 + (c - 3072);
    if (c < 4112) return 3072 + (c - 3088);
    if (c < 5136) return 4096 + pairrow(c - 4112, 0);
    if (c < 6160) return 4096 + pairrow(c - 5136, 1);
    if (c < 7184) return 6400 + pairrow(c - 6160, 0);
    return 6400 + pairrow(c - 7184, 1);
}
__device__ __forceinline__ void xpose_tile(LAS unsigned char* lds, const float* src, int Nsrc, int k0, int c0, bf16_t* dst, int dpitch, int mapid) {
    const int tid = threadIdx.x;
    LAS bf16_t* T = (LAS bf16_t*)lds;
#pragma unroll
    for (int i = 0; i < 2; ++i) { const int kr = (tid >> 4) + 32 * i, c4 = (tid & 15) * 4, c = c0 + c4;
        f32x4 v = (f32x4){0.f, 0.f, 0.f, 0.f}; if (c < Nsrc) v = *(const f32x4*)(src + (size_t)(k0 + kr) * Nsrc + c);
#pragma unroll
        for (int j = 0; j < 4; ++j) T[(c4 + j) * 72 + kr] = f2bf(v[j]); }
    __syncthreads();
    { const int cc = tid >> 3, part = tid & 7, c = c0 + cc;
      if (c < Nsrc) { int R = c; if (mapid == 1) R = map_win(c); else if (mapid == 2) R = c < DFF ? pairrow(c, 0) : pairrow(c - DFF, 1);
          *(u32x4*)(dst + (size_t)R * dpitch + k0 + part * 8) = *(const LAS u32x4*)(T + cc * 72 + part * 8); } }
    __syncthreads();
}
__device__ void phase0(const Params& P, LAS unsigned char* lds) {
    const int tid = threadIdx.x, G = gridDim.x;
    unsigned char* ws = P.ws;
    { u32x4* z = (u32x4*)(ws + WS_WIN + (size_t)6160 * 2048); const int n16 = 240 * 2048 / 16;
      for (int i = blockIdx.x * 512 + tid; i < n16; i += G * 512) z[i] = (u32x4){0u, 0u, 0u, 0u}; }
    for (int task = blockIdx.x; task < 5136; task += G) {
        if (task < 2064) { const int kt = task / 129, ct = task % 129; xpose_tile(lds, P.in[9], 8208, kt * 64, ct * 64, (bf16_t*)(ws + WS_WIN), 1024, 1); }
        else if (task < 2320) { const int t = task - 2064; xpose_tile(lds, P.in[13], 1024, (t >> 4) * 64, (t & 15) * 64, (bf16_t*)(ws + WS_WGC), 1024, 0); }
        else if (task < 2576) { const int t = task - 2320; xpose_tile(lds, P.in[16], 1024, (t >> 4) * 64, (t & 15) * 64, (bf16_t*)(ws + WS_WGC) + (size_t)1024 * 1024, 1024, 0); }
        else if (task < 2832) { const int t = task - 2576; xpose_tile(lds, P.in[17], 1024, (t >> 4) * 64, (t & 15) * 64, (bf16_t*)(ws + WS_WO), 1024, 0); }
        else if (task < 4240) { const int t = task - 2832; xpose_tile(lds, P.in[19], 5632, (t / 88) * 64, (t % 88) * 64, (bf16_t*)(ws + WS_WF1), 1024, 2); }
        else if (task < 4944) { const int t = task - 4240; xpose_tile(lds, P.in[20], 1024, (t >> 4) * 64, (t & 15) * 64, (bf16_t*)(ws + WS_WF2), DFF, 0); }
        else {
            const int n0 = (task - 4944) * 32;
            LAS float* CL = (LAS float*)lds; LAS float* RED = (LAS float*)(lds + 81920);
            for (int idx = tid; idx < 20480; idx += 512) { const int r = idx >> 10, k = idx & 1023; CL[idx] = r < 4 ? P.in[2][r * 1024 + k] : P.in[3][(r - 4) * 1024 + k]; }
            __syncthreads();
            const int col = tid & 31, ks = tid >> 5; float a[20];
#pragma unroll
            for (int r = 0; r < 20; ++r) a[r] = 0.f;
            const float* wp = P.in[6] + (size_t)(ks * 64) * NMOD + n0 + col;
            for (int kk = 0; kk < 64; ++kk) { const float w = wp[(size_t)kk * NMOD]; const int k = ks * 64 + kk;
#pragma unroll
                for (int r = 0; r < 20; ++r) a[r] += CL[r * 1024 + k] * w; }
#pragma unroll
            for (int r = 0; r < 20; ++r) RED[(ks * 20 + r) * 32 + col] = a[r];
            __syncthreads();
            for (int o = tid; o < 640; o += 512) { const int r = o >> 5, cc = o & 31; float s = P.in[7][n0 + cc];
                for (int q = 0; q < 16; ++q) s += RED[(q * 20 + r) * 32 + cc];
                ((float*)(ws + WS_MOD))[r * NMOD + n0 + cc] = s; }
            __syncthreads();
        }
    }
}

__device__ void phase_norm_mod(const float* x0, const float* x1, const float* gamma, const float* mod, int sh_off, int sc_off, bf16_t* H) {
    const int lane = threadIdx.x & 63, wid = threadIdx.x >> 6;
    for (int row = blockIdx.x * 8 + wid; row < MTOT; row += gridDim.x * 8) {
        const float* xp = row < MP ? x0 + (size_t)row * 1024 : x1 + (size_t)(row - MP) * 1024;
        f32x4 v[4]; float ss = 0.f;
#pragma unroll
        for (int i = 0; i < 2; ++i) { v[2 * i] = *(const f32x4*)(xp + i * 512 + lane * 8); v[2 * i + 1] = *(const f32x4*)(xp + i * 512 + lane * 8 + 4); }
#pragma unroll
        for (int i = 0; i < 4; ++i) ss += v[i][0] * v[i][0] + v[i][1] * v[i][1] + v[i][2] * v[i][2] + v[i][3] * v[i][3];
#pragma unroll
        for (int o = 32; o >= 1; o >>= 1) ss += __shfl_xor(ss, o);
        const float rstd = rsqrtf(ss * (1.0f / 1024.0f) + EPS);
        const float* mp = mod + (size_t)modrow_of(row) * NMOD;
#pragma unroll
        for (int i = 0; i < 2; ++i) { const int c = i * 512 + lane * 8; float o[8];
#pragma unroll
            for (int hlf = 0; hlf < 2; ++hlf) { const f32x4 g = *(const f32x4*)(gamma + c + 4 * hlf), sc = *(const f32x4*)(mp + sc_off + c + 4 * hlf), sh = *(const f32x4*)(mp + sh_off + c + 4 * hlf);
#pragma unroll
                for (int j = 0; j < 4; ++j) o[4 * hlf + j] = v[2 * i + hlf][j] * rstd * g[j] * (1.0f + sc[j]) + sh[j]; }
            u32x4 w; w.x = cvt_pk_bf16(o[0], o[1]); w.y = cvt_pk_bf16(o[2], o[3]); w.z = cvt_pk_bf16(o[4], o[5]); w.w = cvt_pk_bf16(o[6], o[7]);
            *(u32x4*)(H + (size_t)row * 1024 + c) = w; }
    }
}
__device__ void phase_final_norm(float* x, const float* gamma) {
    const int lane = threadIdx.x & 63, wid = threadIdx.x >> 6;
    for (int row = blockIdx.x * 8 + wid; row < MTOT; row += gridDim.x * 8) {
        float* xp = x + (size_t)row * 1024; f32x4 v[4]; float ss = 0.f;
#pragma unroll
        for (int i = 0; i < 4; ++i) v[i] = *(const f32x4*)(xp + i * 256 + lane * 4);
#pragma unroll
        for (int i = 0; i < 4; ++i) ss += v[i][0] * v[i][0] + v[i][1] * v[i][1] + v[i][2] * v[i][2] + v[i][3] * v[i][3];
#pragma unroll
        for (int o = 32; o >= 1; o >>= 1) ss += __shfl_xor(ss, o);
        const float rstd = rsqrtf(ss * (1.0f / 1024.0f) + EPS);
#pragma unroll
        for (int i = 0; i < 4; ++i) { const f32x4 g = *(const f32x4*)(gamma + i * 256 + lane * 4); *(f32x4*)(xp + i * 256 + lane * 4) = v[i] * rstd * g; }
    }
}

__device__ void conv_block(const Params& P, int blk) {
    const int tid = threadIdx.x, cgp = tid & 127, rg = tid >> 7, c0 = cgp * 8;
    const int row0 = blk * 64 + rg * 16;
    const bf16_t* zp = (const bf16_t*)(P.ws + Z_P); bf16_t* zcb = (bf16_t*)(P.ws + Z_CB);
    int seq0, seqlen; float* cache_out;
    if (row0 < MP) { seq0 = row0 & ~4095; seqlen = 4096; cache_out = P.out + O_CP + (size_t)(row0 >> 12) * 2048; }
    else { const int sb = (row0 - MP) >> 5; seq0 = MP + sb * 32; seqlen = 32; cache_out = P.out + O_CS + (size_t)sb * 2048; }
    float w0[8], w1[8], w2[8], bs[8], p1[8], p2[8];
#pragma unroll
    for (int j = 0; j < 8; ++j) { w0[j] = P.in[14][c0 + j]; w1[j] = P.in[14][1024 + c0 + j]; w2[j] = P.in[14][2048 + c0 + j]; bs[j] = P.in[15][c0 + j]; }
    if (row0 == seq0) {
        if (row0 < MP) {
#pragma unroll
            for (int j = 0; j < 8; ++j) { p1[j] = 0.f; p2[j] = 0.f; }
        } else { const float* cp = P.in[5] + (size_t)((row0 - MP) >> 5) * 2048 + c0;
#pragma unroll
            for (int j = 0; j < 8; ++j) { p2[j] = cp[j]; p1[j] = cp[1024 + j]; } }
    } else {
        const u32x4 a = *(const u32x4*)(zp + (size_t)(row0 - 1) * 1024 + c0), b = *(const u32x4*)(zp + (size_t)(row0 - 2) * 1024 + c0);
        p1[0] = bf_lo(a.x); p1[1] = bf_hi(a.x); p1[2] = bf_lo(a.y); p1[3] = bf_hi(a.y); p1[4] = bf_lo(a.z); p1[5] = bf_hi(a.z); p1[6] = bf_lo(a.w); p1[7] = bf_hi(a.w);
        p2[0] = bf_lo(b.x); p2[1] = bf_hi(b.x); p2[2] = bf_lo(b.y); p2[3] = bf_hi(b.y); p2[4] = bf_lo(b.z); p2[5] = bf_hi(b.z); p2[6] = bf_lo(b.w); p2[7] = bf_hi(b.w);
    }
    for (int i = 0; i < 16; ++i) { const int r = row0 + i;
        const u32x4 a = *(const u32x4*)(zp + (size_t)r * 1024 + c0), b = *(const u32x4*)(zcb + (size_t)r * 1024 + c0);
        float p0[8], cb[8], u[8];
        p0[0] = bf_lo(a.x); p0[1] = bf_hi(a.x); p0[2] = bf_lo(a.y); p0[3] = bf_hi(a.y); p0[4] = bf_lo(a.z); p0[5] = bf_hi(a.z); p0[6] = bf_lo(a.w); p0[7] = bf_hi(a.w);
        cb[0] = bf_lo(b.x); cb[1] = bf_hi(b.x); cb[2] = bf_lo(b.y); cb[3] = bf_hi(b.y); cb[4] = bf_lo(b.z); cb[5] = bf_hi(b.z); cb[6] = bf_lo(b.w); cb[7] = bf_hi(b.w);
#pragma unroll
        for (int j = 0; j < 8; ++j) u[j] = cb[j] * (p2[j] * w0[j] + p1[j] * w1[j] + p0[j] * w2[j] + bs[j]);
        u32x4 w; w.x = cvt_pk_bf16(u[0], u[1]); w.y = cvt_pk_bf16(u[2], u[3]); w.z = cvt_pk_bf16(u[4], u[5]); w.w = cvt_pk_bf16(u[6], u[7]);
        *(u32x4*)(zcb + (size_t)r * 1024 + c0) = w;
        const int pos = r - seq0;
        if (pos >= seqlen - 2) { float* co = cache_out + (size_t)(pos - (seqlen - 2)) * 1024 + c0;
            *(f32x4*)co = (f32x4){p0[0], p0[1], p0[2], p0[3]}; *(f32x4*)(co + 4) = (f32x4){p0[4], p0[5], p0[6], p0[7]}; }
#pragma unroll
        for (int j = 0; j < 8; ++j) { p2[j] = p1[j]; p1[j] = p0[j]; }
    }
}

constexpr int L_QE = 0, L_KE = 17408, L_KLT = 34816, L_VT = 53248, L_SC = 90112, L_AL = 99328, L_PSUM = 103424, L_EDEC = 105472, L_PART = 105984, L_LA = 108032, L_GN = 140800;
#define MFMA32(a, b, c) __builtin_amdgcn_mfma_f32_32x32x16_bf16(a, b, c, 0, 0, 0)

template <bool OUT>
__device__ void gla_walk(const Params& P, LAS unsigned char* lds, int h, int tok0, int nchunks, int nvalid, const float* Sinit, float* Sfinal, float* Dout) {
    const int tid = threadIdx.x, lane = tid & 63, w = __builtin_amdgcn_readfirstlane(tid >> 6), r = lane & 31, hh = lane >> 5;
    const int d = tid & 127, tq = tid >> 7;
    const bf16_t* zq = (const bf16_t*)(P.ws + Z_Q); const bf16_t* zk = (const bf16_t*)(P.ws + Z_K); const bf16_t* zv = (const bf16_t*)(P.ws + Z_V);
    bf16_t* zg = (bf16_t*)(P.ws + Z_G); const bf16_t* za = (const bf16_t*)(P.ws + Z_A);
    LAS bf16_t* QE = (LAS bf16_t*)(lds + L_QE); LAS bf16_t* KE = (LAS bf16_t*)(lds + L_KE); LAS bf16_t* KLT = (LAS bf16_t*)(lds + L_KLT);
    LAS bf16_t* VT = (LAS bf16_t*)(lds + L_VT); LAS bf16_t* SC = (LAS bf16_t*)(lds + L_SC);
    LAS float* AL = (LAS float*)(lds + L_AL); LAS float* PSUM = (LAS float*)(lds + L_PSUM); LAS float* EDEC = (LAS float*)(lds + L_EDEC); LAS float* PART = (LAS float*)(lds + L_PART); LAS float* LA = (LAS float*)(lds + L_LA); LAS float* GN = (LAS float*)(lds + L_GN);

    f32x16 S[4];
#pragma unroll
    for (int db = 0; db < 4; ++db)
#pragma unroll
        for (int g = 0; g < 16; ++g) S[db][g] = 0.f;
    if (Sinit) { const float* sp = Sinit + (size_t)(4 * hh) * 256 + 32 * w + r;
#pragma unroll
        for (int db = 0; db < 4; ++db)
#pragma unroll
            for (int q4 = 0; q4 < 4; ++q4) { const float* p = sp + (size_t)(32 * db + 8 * q4) * 256; asm volatile("" : "+v"(p));
                S[db][4 * q4 + 0] = p[0]; S[db][4 * q4 + 1] = p[256]; S[db][4 * q4 + 2] = p[512]; S[db][4 * q4 + 3] = p[768]; } }
    float wal[16];
#pragma unroll
    for (int q = 0; q < 16; ++q) wal[q] = P.in[10][q * 512 + h * 128 + d];
    const float bal = P.in[11][h * 128 + d];
    if (OUT && tid < 256) GN[tid] = P.in[12][tid];
    float dsum = 0.f;

    for (int ck = 0; ck < nchunks; ++ck, tok0 += 64) {
        { const int idx = tid * 2, t = idx >> 4, rr = idx & 15; unsigned two = 0u; if (t < nvalid) two = *(const unsigned*)(za + (size_t)(tok0 + t) * 256 + rr);
          AL[t * 16 + rr] = bf_lo(two); AL[t * 16 + rr + 1] = bf_hi(two); }
        { const int t = tid >> 3;
#pragma unroll
          for (int i = 0; i < 4; ++i) { const int v8 = (tid & 7) * 8 + 64 * i; u32x4 x = (u32x4){0u, 0u, 0u, 0u};
              if (t < nvalid) x = *(const u32x4*)(zv + (size_t)(tok0 + t) * 1024 + h * 256 + v8);
              VT[(v8 + 0) * 72 + t] = (bf16_t)(x.x & 0xffff); VT[(v8 + 1) * 72 + t] = (bf16_t)(x.x >> 16); VT[(v8 + 2) * 72 + t] = (bf16_t)(x.y & 0xffff); VT[(v8 + 3) * 72 + t] = (bf16_t)(x.y >> 16);
              VT[(v8 + 4) * 72 + t] = (bf16_t)(x.z & 0xffff); VT[(v8 + 5) * 72 + t] = (bf16_t)(x.z >> 16); VT[(v8 + 6) * 72 + t] = (bf16_t)(x.w & 0xffff); VT[(v8 + 7) * 72 + t] = (bf16_t)(x.w >> 16); } }
        __syncthreads();
        float run = 0.f;
#pragma unroll 4
        for (int tt = 0; tt < 16; ++tt) { const int t = 16 * tq + tt; float x = bal;
#pragma unroll
            for (int q = 0; q < 16; ++q) x += AL[t * 16 + q] * wal[q];
            float la = (fminf(x, 0.f) - __logf(1.0f + __expf(-fabsf(x)))) * (1.0f / 16.0f);
            if (t >= nvalid) la = 0.f;
            run += la; LA[t * 128 + d] = run; }
        PSUM[tq * 128 + d] = run;
        __syncthreads();
        float off = 0.f, blast = 0.f;
#pragma unroll
        for (int q = 0; q < 4; ++q) { const float ps = PSUM[q * 128 + d]; blast += ps; if (q < tq) off += ps; }
        if (tq == 0) { EDEC[d] = __expf(blast); dsum += blast; }
        { const bf16_t* kp = zk + (size_t)(tok0 + 16 * tq) * 512 + h * 128 + d; const bf16_t* qp = zq + (size_t)(tok0 + 16 * tq) * 512 + h * 128 + d;
#pragma unroll 1
          for (int t4 = 0; t4 < 16; t4 += 4) { float kk[4], qq[4], bb[4];
#pragma unroll
              for (int j = 0; j < 4; ++j) { const int t = 16 * tq + t4 + j; const bool ok = t < nvalid;
                  kk[j] = ok ? bf2f(kp[(size_t)(t4 + j) * 512]) : 0.f; qq[j] = (OUT && ok) ? bf2f(qp[(size_t)(t4 + j) * 512]) : 0.f; bb[j] = off + LA[t * 128 + d]; }
              *(LAS u32x2*)(KLT + d * 72 + 16 * tq + t4) = (u32x2){cvt_pk_bf16(kk[0] * __expf(blast - bb[0]), kk[1] * __expf(blast - bb[1])), cvt_pk_bf16(kk[2] * __expf(blast - bb[2]), kk[3] * __expf(blast - bb[3]))};
              if (OUT) {
#pragma unroll
                  for (int j = 0; j < 4; ++j) { const int t = 16 * tq + t4 + j;
                      QE[t * 136 + d] = f2bf(qq[j] * 0.08838834764831845f * __expf(bb[j])); KE[t * 136 + d] = f2bf(kk[j] * __expf(-bb[j])); } } } }
        __syncthreads();
        if (OUT) {
            if (w < 3) { const int jb = (w == 2) ? 1 : 0, ib = (w == 0) ? 0 : 1;
                f32x16 a = {0.f, 0.f, 0.f, 0.f, 0.f, 0.f, 0.f, 0.f, 0.f, 0.f, 0.f, 0.f, 0.f, 0.f, 0.f, 0.f};
#pragma unroll
                for (int ks = 0; ks < 8; ++ks) { const bf16x8 A = *(const LAS bf16x8*)(KE + (32 * jb + r) * 136 + 16 * ks + 8 * hh), B = *(const LAS bf16x8*)(QE + (32 * ib + r) * 136 + 16 * ks + 8 * hh);
                    a = MFMA32(A, B, a); }
                const int i = 32 * ib + r;
#pragma unroll
                for (int g = 0; g < 4; ++g) { const int j0 = 32 * jb + 8 * g + 4 * hh; float e[4];
#pragma unroll
                    for (int q = 0; q < 4; ++q) e[q] = (j0 + q <= i) ? a[4 * g + q] : 0.f;
                    *(LAS u32x2*)(SC + i * 72 + j0) = (u32x2){cvt_pk_bf16(e[0], e[1]), cvt_pk_bf16(e[2], e[3])}; }
            } else if (w == 3) {
#pragma unroll
                for (int g = 0; g < 4; ++g) *(LAS u32x2*)(SC + r * 72 + 32 + 8 * g + 4 * hh) = (u32x2){0u, 0u};
            }
            __syncthreads();
        }
        bf16x8 vf[4];
#pragma unroll
        for (int ks = 0; ks < 4; ++ks) vf[ks] = *(const LAS bf16x8*)(VT + (32 * w + r) * 72 + 16 * ks + 8 * hh);
        f32x16 oT[2];
        if (OUT) {
#pragma unroll
            for (int ib = 0; ib < 2; ++ib)
#pragma unroll
                for (int g = 0; g < 16; ++g) oT[ib][g] = 0.f;
#pragma unroll
            for (int db = 0; db < 4; ++db)
#pragma unroll
                for (int s = 0; s < 2; ++s) {
                    u32x4 ap; ap.x = cvt_pk_bf16(S[db][8 * s + 0], S[db][8 * s + 1]); ap.y = cvt_pk_bf16(S[db][8 * s + 2], S[db][8 * s + 3]);
                    ap.z = cvt_pk_bf16(S[db][8 * s + 4], S[db][8 * s + 5]); ap.w = cvt_pk_bf16(S[db][8 * s + 6], S[db][8 * s + 7]);
                    const bf16x8 A = __builtin_bit_cast(bf16x8, ap);
#pragma unroll
                    for (int ib = 0; ib < 2; ++ib) { const int i = 32 * ib + r;
                        const u32x2 lo = *(const LAS u32x2*)(QE + i * 136 + 32 * db + 16 * s + 4 * hh), hi = *(const LAS u32x2*)(QE + i * 136 + 32 * db + 16 * s + 8 + 4 * hh);
                        const u32x4 bp = (u32x4){lo.x, lo.y, hi.x, hi.y};
                        oT[ib] = MFMA32(A, __builtin_bit_cast(bf16x8, bp), oT[ib]); }
                    __builtin_amdgcn_sched_barrier(0); }
#pragma unroll
            for (int ks = 0; ks < 4; ++ks)
#pragma unroll
                for (int ib = 0; ib < 2; ++ib) { const bf16x8 B = *(const LAS bf16x8*)(SC + (32 * ib + r) * 72 + 16 * ks + 8 * hh); oT[ib] = MFMA32(vf[ks], B, oT[ib]); }
            __builtin_amdgcn_sched_barrier(0);
        }
#pragma unroll
        for (int db = 0; db < 4; ++db) {
#pragma unroll
            for (int g = 0; g < 4; ++g) { const f32x4 e = *(const LAS f32x4*)(EDEC + 32 * db + 8 * g + 4 * hh);
                S[db][4 * g + 0] *= e[0]; S[db][4 * g + 1] *= e[1]; S[db][4 * g + 2] *= e[2]; S[db][4 * g + 3] *= e[3]; }
#pragma unroll
            for (int ks = 0; ks < 4; ++ks) { const bf16x8 A = *(const LAS bf16x8*)(KLT + (32 * db + r) * 72 + 16 * ks + 8 * hh); S[db] = MFMA32(A, vf[ks], S[db]); }
            __builtin_amdgcn_sched_barrier(0);
        }
        if (OUT) {
#pragma unroll
            for (int ib = 0; ib < 2; ++ib) { float ss = 0.f;
#pragma unroll
                for (int g = 0; g < 16; ++g) ss += oT[ib][g] * oT[ib][g];
                ss += __shfl_xor(ss, 32);
                if (hh == 0) PART[w * 64 + 32 * ib + r] = ss; }
            __syncthreads();
#pragma unroll
            for (int ib = 0; ib < 2; ++ib) { const int t = 32 * ib + r; float tot = 0.f;
#pragma unroll
                for (int q = 0; q < 8; ++q) tot += PART[q * 64 + t];
                const float rstd = rsqrtf(tot * (1.0f / 256.0f) + EPS);
                if (t < nvalid) { bf16_t* gp = zg + (size_t)(tok0 + t) * 1024 + h * 256 + 32 * w + 4 * hh;
#pragma unroll
                    for (int g = 0; g < 4; ++g) { const u32x2 gg = *(const u32x2*)(gp + 8 * g); const f32x4 gn = *(const LAS f32x4*)(GN + 32 * w + 8 * g + 4 * hh);
                        const float g0 = bf_lo(gg.x), g1 = bf_hi(gg.x), g2 = bf_lo(gg.y), g3 = bf_hi(gg.y);
                        const float o0 = oT[ib][4 * g + 0] * rstd * gn[0] * g0 / (1.0f + __expf(-g0));
                        const float o1 = oT[ib][4 * g + 1] * rstd * gn[1] * g1 / (1.0f + __expf(-g1));
                        const float o2 = oT[ib][4 * g + 2] * rstd * gn[2] * g2 / (1.0f + __expf(-g2));
                        const float o3 = oT[ib][4 * g + 3] * rstd * gn[3] * g3 / (1.0f + __expf(-g3));
                        *(u32x2*)(gp + 8 * g) = (u32x2){cvt_pk_bf16(o0, o1), cvt_pk_bf16(o2, o3)}; } } }
        }
        __syncthreads();
    }
    if (Sfinal) { float* sp = Sfinal + (size_t)(4 * hh) * 256 + 32 * w + r;
#pragma unroll
        for (int db = 0; db < 4; ++db)
#pragma unroll
            for (int q4 = 0; q4 < 4; ++q4) { float* p = sp + (size_t)(32 * db + 8 * q4) * 256; asm volatile("" : "+v"(p));
                p[0] = S[db][4 * q4 + 0]; p[256] = S[db][4 * q4 + 1]; p[512] = S[db][4 * q4 + 2]; p[768] = S[db][4 * q4 + 3]; } }
    if (Dout && tq == 0) Dout[d] = __expf(dsum);
}

__global__ void __launch_bounds__(512, 2) fwd_megakernel(Params P) {
    extern __shared__ __attribute__((aligned(16))) unsigned char lds_raw[];
    LAS unsigned char* lds = (LAS unsigned char*)lds_raw;
    cg::grid_group grid = cg::this_grid();
    const int G = gridDim.x, bid = blockIdx.x, tid = threadIdx.x;
    unsigned char* ws = P.ws;
    float* mod = (float*)(ws + WS_MOD);
    bf16_t* Hb = (bf16_t*)(ws + WS_H);
    bf16_t* Rg = (bf16_t*)P.out;
    bf16_t* Gg = Rg + (size_t)MTOT * 1024;

#ifndef PHMASK
#define PHMASK 0xffff
#endif
#define PH(n) if ((PHMASK >> (n)) & 1)
    PH(0) phase0(P, lds);
    grid.sync();
    PH(1) phase_norm_mod(P.in[0], P.in[1], P.in[8], mod, 0, 1024, Hb);
    grid.sync();
    PH(2) { pg8::Gemm g{Hb, (const bf16_t*)(ws + WS_WIN), 1024}; pg8::Order S; S.init(66, 33, G, bid);
      EpiIn E{ws, Rg, Gg}; pg8::gemm_phase<EpiIn>(lds, g, S, E); }
    grid.sync();
    PH(3) for (int it = bid; it < 304; it += G) {
        if (it < 240) { const int bh = it / 15, seg = it % 15, b = bh >> 2, h = bh & 3;
            gla_walk<false>(P, lds, h, b * 4096 + seg * (SEGCH * 64), SEGCH, 64, nullptr, (float*)(ws + SEG_STATE) + (size_t)(bh * 16 + seg) * 32768, (float*)(ws + SEG_DEC) + (size_t)(bh * 16 + seg) * 128);
        } else { const int sbh = it - 240, sb = sbh >> 2, h = sbh & 3;
            gla_walk<true>(P, lds, h, MP + sb * 32, 1, 32, P.in[4] + (size_t)sbh * 32768, P.out + O_SS + (size_t)sbh * 32768, nullptr); }
    }
    PH(4) for (int blk = bid; blk < 264; blk += G) conv_block(P, blk);
    grid.sync();
    for (int e4 = bid * 512 + tid; e4 < 16 * 8192; e4 += G * 512) { const int bh = e4 >> 13, idx = (e4 & 8191) * 4, dd = idx >> 8;
        f32x4 s = (f32x4){0.f, 0.f, 0.f, 0.f};
        for (int seg = 0; seg < 15; ++seg) { float* lp = (float*)(ws + SEG_STATE) + (size_t)(bh * 16 + seg) * 32768 + idx;
            const float dc = ((const float*)(ws + SEG_DEC))[(bh * 16 + seg) * 128 + dd];
            s = s * dc + *(const f32x4*)lp; *(f32x4*)lp = s; } }
    grid.sync();
    PH(5) for (int it = bid; it < 256; it += G) { const int bh = it >> 4, seg = it & 15, b = bh >> 2, h = bh & 3;
        gla_walk<true>(P, lds, h, b * 4096 + seg * (SEGCH * 64), SEGCH, 64, seg ? (const float*)(ws + SEG_STATE) + (size_t)(bh * 16 + seg - 1) * 32768 : nullptr,
                       seg == 15 ? P.out + O_SP + (size_t)bh * 32768 : nullptr, nullptr); }
    grid.sync();
    PH(6) { pg8::Gemm g{(const bf16_t*)(ws + Z_G), (const bf16_t*)(ws + WS_WGC), 1024}; pg8::Order S; S.init(66, 4, G, bid, 1, 66, 4);
      EpiMerge E{Rg, Gg, (bf16_t*)(ws + Z_V)}; pg8::gemm_phase<EpiMerge>(lds, g, S, E); }
    grid.sync();
    PH(7) { pg8::Gemm g{(const bf16_t*)(ws + Z_V), (const bf16_t*)(ws + WS_WO), 1024}; pg8::Order S; S.init(66, 4, G, bid);
      EpiRes E{P.in[0], P.in[1], P.out, mod + 2048}; pg8::gemm_phase<EpiRes>(lds, g, S, E); }
    grid.sync();
    PH(8) phase_norm_mod(P.out, P.out + (size_t)MP * 1024, P.in[18], mod, 3072, 4096, Hb);
    grid.sync();
    PH(9) { pg8::Gemm g{Hb, (const bf16_t*)(ws + WS_WF1), 1024}; pg8::Order S; S.init(66, 22, G, bid);
      EpiAct E{(bf16_t*)(ws + WS_Z)}; pg8::gemm_phase<EpiAct>(lds, g, S, E); }
    grid.sync();
    PH(10) { pg8::Gemm g{(const bf16_t*)(ws + WS_Z), (const bf16_t*)(ws + WS_WF2), DFF}; pg8::Order S; S.init(66, 4, G, bid);
      EpiRes E{P.out, P.out + (size_t)MP * 1024, P.out, mod + 5120}; pg8::gemm_phase<EpiRes>(lds, g, S, E); }
    grid.sync();
    PH(11) phase_final_norm(P.out, P.in[21]);
}

extern "C" void kernel_launch(void* const* d_in, const int* in_sizes, int n_in, void* d_out, int out_size, void* d_ws, size_t ws_size, hipStream_t stream) {
    static int grid_blocks = 0;
    if (grid_blocks == 0) {
        if (n_in != 22 || ws_size < WS_END) { fprintf(stderr, "kernel_launch: unexpected n_in %d / ws %zu (need %zu)\n", n_in, ws_size, (size_t)WS_END); grid_blocks = -1; return; }
        int dev = 0, cus = 0, per_cu = 0;
        hipGetDevice(&dev); hipDeviceGetAttribute(&cus, hipDeviceAttributeMultiprocessorCount, dev);
        if (hipFuncSetAttribute((const void*)fwd_megakernel, hipFuncAttributeMaxDynamicSharedMemorySize, LDS_BYTES) != hipSuccess) { fprintf(stderr, "kernel_launch: hipFuncSetAttribute failed\n"); grid_blocks = -1; return; }
        hipOccupancyMaxActiveBlocksPerMultiprocessor(&per_cu, (const void*)fwd_megakernel, 512, LDS_BYTES);
        (void)hipGetLastError();
        if (per_cu < 1) per_cu = 1;
        grid_blocks = cus;
        fprintf(stderr, "kernel_launch: cus %d per_cu %d grid %d\n", cus, per_cu, grid_blocks);
    }
    if (grid_blocks < 0) return;
    Params p{};
    for (int i = 0; i < 22; ++i) p.in[i] = (const float*)d_in[i];
    p.out = (float*)d_out; p.ws = (unsigned char*)d_ws;
    void* args[] = {&p};
    hipError_t e = hipLaunchCooperativeKernel((const void*)fwd_megakernel, dim3(grid_blocks), dim3(512), args, LDS_BYTES, stream);
    if (e != hipSuccess) fprintf(stderr, "cooperative launch failed: %s (grid %d)\n", hipGetErrorString(e), grid_blocks);
}
```

```cpp
#include <hip/hip_runtime.h>
#include <hip/hip_cooperative_groups.h>
#include <cstdio>
#include <cstdint>
namespace cg = cooperative_groups;

#define LAS __attribute__((address_space(3)))
typedef unsigned short bf16_t;
typedef short bf16x8 __attribute__((ext_vector_type(8)));
typedef float f32x4 __attribute__((ext_vector_type(4)));
typedef float f32x16 __attribute__((ext_vector_type(16)));
typedef unsigned u32x4 __attribute__((ext_vector_type(4)));
typedef unsigned u32x2 __attribute__((ext_vector_type(2)));

constexpr int DM = 1024, MP = 16384, MTOT = 16896, NMODROW = 20, NMOD = 6144;
constexpr int NIN = 8448;
constexpr int DFF = 2816;
constexpr int NSEG = 16, SEGCH = 4;
constexpr float EPS = 1e-6f;

constexpr size_t WS_WIN = 0;
constexpr size_t WS_WGC = WS_WIN + (size_t)NIN * 1024 * 2;
constexpr size_t WS_WO  = WS_WGC + (size_t)2 * 1024 * 1024 * 2;
constexpr size_t WS_WF1 = WS_WO + (size_t)1024 * 1024 * 2;
constexpr size_t WS_WF2 = WS_WF1 + (size_t)5632 * 1024 * 2;
constexpr size_t WS_MOD = WS_WF2 + (size_t)1024 * 2816 * 2;
constexpr size_t WS_H   = WS_MOD + (size_t)NMODROW * NMOD * 4;
constexpr size_t WS_Z   = WS_H + (size_t)MTOT * 1024 * 2;
constexpr size_t Z_Q = WS_Z;
constexpr size_t Z_K = Z_Q + (size_t)MTOT * 512 * 2;
constexpr size_t Z_V = Z_K + (size_t)MTOT * 512 * 2;
constexpr size_t Z_G = Z_V + (size_t)MTOT * 1024 * 2;
constexpr size_t Z_CB = Z_G + (size_t)MTOT * 1024 * 2;
constexpr size_t Z_P = Z_CB + (size_t)MTOT * 1024 * 2;
constexpr size_t Z_A = Z_P + (size_t)MTOT * 1024 * 2;
constexpr size_t WS_BAR = Z_A + (size_t)MTOT * 256 * 2;
constexpr size_t WS_END = WS_BAR + 16384;
constexpr size_t SEG_STATE = WS_H;
constexpr size_t SEG_DEC = WS_H + (size_t)16 * 16 * 32768 * 4;
static_assert(SEG_DEC + 16 * 16 * 128 * 4 <= WS_Z, "seg state fits in H");
static_assert(WS_END <= (size_t)256 * 1024 * 1024, "ws");
constexpr size_t O_Y = 0, O_SP = 17301504, O_CP = 17825792, O_SS = 17833984, O_CS = 19931136;

constexpr int LDS_BYTES = 144 * 1024;
#ifndef PROBE_DUP
#define PROBE_DUP 0
#endif
#ifndef PROBE_P0
#define PROBE_P0 0
#endif
#ifndef PROBE_NORM
#define PROBE_NORM 0
#endif
#ifndef PROBE_GLA1
#define PROBE_GLA1 0
#endif
#ifndef PROBE_SYNC
#define PROBE_SYNC 0
#endif

struct Params { const float* in[22]; float* out; unsigned char* ws; };

__device__ __forceinline__ unsigned cvt_pk_bf16(float lo, float hi) { unsigned r; asm("v_cvt_pk_bf16_f32 %0, %1, %2" : "=v"(r) : "v"(lo), "v"(hi)); return r; }
__device__ __forceinline__ float bf_lo(unsigned w) { return __uint_as_float(w << 16); }
__device__ __forceinline__ float bf_hi(unsigned w) { return __uint_as_float(w & 0xffff0000u); }
__device__ __forceinline__ float bf2f(bf16_t b) { return __uint_as_float(((unsigned)b) << 16); }
__device__ __forceinline__ bf16_t f2bf(float f) { return (bf16_t)(cvt_pk_bf16(f, 0.f) & 0xffffu); }
__device__ __forceinline__ float sigmoidf_(float x) { return 1.0f / (1.0f + __expf(-x)); }
__device__ __forceinline__ int modrow_of(int row) { return row < MP ? (row >> 12) : 4 + ((row - MP) >> 5); }

namespace pg8 {
constexpr int BM = 256, BK = 64, HALF = 128, HTB = HALF * BK * 2, STAGE_BYTES = 8 * HTB, NXCD = 8, WGM = 8;
__host__ __device__ __forceinline__ int lds_byte(int r, int c) { const int st = (r >> 4) * 2 + (c >> 5), rr = r & 15, cc = c & 31, ob = rr * 64 + cc * 2; return st * 1024 + (ob ^ (((ob >> 9) & 1) << 5)); }
__host__ __device__ __forceinline__ void stage_rc(int b, int& R, int& C) { const int st = b / 1024, sb = b % 1024, swz = sb ^ (((sb >> 9) & 1) << 5); R = (st >> 1) * 16 + swz / 64; C = (st & 1) * 32 + (swz % 64) / 2; }
__host__ __device__ __forceinline__ int perm32(int rho) { const int n = rho >> 4, i = rho & 15; return 8 * (i >> 2) + 4 * n + (i & 3); }

struct Unit { int pm, pn; };
struct Gemm { const bf16_t* A; const bf16_t* Bt; int K; };

struct Order {
    int nM, nN, nwg, G, c, paired, dpm, dpn;
    __device__ void init(int nM_, int nN_, int G_, int c_, int paired_ = 0, int dpm_ = 0, int dpn_ = 0) { nM = nM_; nN = nN_; nwg = nM * nN; G = G_; c = c_; paired = paired_; dpm = dpm_; dpn = dpn_; }
    __device__ bool next(int i, Unit& u) const {
        const int it = paired ? (i >> 1) : i;
        const long L = (long)it * G + c; if (L >= nwg) return false;
        int wgid = (int)L; { const int q = nwg / NXCD, r = nwg % NXCD, xcd = wgid % NXCD, off = wgid / NXCD; wgid = (xcd < r ? xcd * (q + 1) : r * (q + 1) + (xcd - r) * q) + off; }
        const int nig = WGM * nN, gid = wgid / nig, fm = gid * WGM, gsz = (nM - fm) < WGM ? (nM - fm) : WGM;
        u.pm = fm + ((wgid % nig) % gsz); u.pn = (wgid % nig) / gsz;
        if (paired && (i & 1)) { u.pm += dpm; u.pn += dpn; }
        return true;
    }
};

template <class Epi>
__device__ __forceinline__ void gemm_phase(LAS unsigned char* lds, const Gemm g, const Order& S, const Epi& E) {
    const int tid = threadIdx.x, wid = __builtin_amdgcn_readfirstlane(tid >> 6), lane = tid & 63, wr = wid >> 2, wc = wid & 3, fr = lane & 15, fq = lane >> 4;
    const int K = g.K, nt = K / BK;
    unsigned voffA[2], voffB[2];
#pragma unroll
    for (int i = 0; i < 2; ++i) { int R, C; stage_rc(tid * 16 + i * 8192, R, C); const int Rb = Epi::PERM ? ((R & ~31) + perm32(R & 31)) : R;
        voffA[i] = (unsigned)(R * K + C) * 2u; voffB[i] = (unsigned)(Rb * K + C) * 2u; }
    const size_t kstep = (size_t)(BK * 2);
    const size_t hstep = (size_t)HALF * K * 2;
    const size_t tstep = 2 * hstep;
    const unsigned ldsw = (unsigned)wid * 1024u;
    const int aoff = lds_byte(wr * 64 + fr, fq * 8), boff = lds_byte(wc * 32 + fr, fq * 8);
#define PG8_SA(b, h) (((b) * 2 + (h)) * HTB)
#define PG8_SB(b, h) ((4 + (b) * 2 + (h)) * HTB)
#define PG8_STAGE(bufoff, gbase, voff) do { _Pragma("unroll") for (int _i = 0; _i < 2; ++_i) \
        __builtin_amdgcn_global_load_lds((const unsigned*)((const char*)(gbase) + (voff)[_i]), (LAS unsigned*)(lds + (bufoff) + ldsw + _i * 8192), 16, 0, 0); } while (0)
#define PG8_LDA(dst, b, h) do { _Pragma("unroll") for (int m = 0; m < 4; ++m) _Pragma("unroll") for (int k = 0; k < 2; ++k) dst[m][k] = *(const LAS bf16x8*)(lds + PG8_SA(b, h) + aoff + m * 2048 + k * 1024); } while (0)
#define PG8_LDB(dst, b, h) do { _Pragma("unroll") for (int n = 0; n < 2; ++n) _Pragma("unroll") for (int k = 0; k < 2; ++k) dst[n][k] = *(const LAS bf16x8*)(lds + PG8_SB(b, h) + boff + n * 2048 + k * 1024); } while (0)
#define PG8_MMA(ai, bj, At, Bt) do { __builtin_amdgcn_s_setprio(1); _Pragma("unroll") for (int m = 0; m < 4; ++m) _Pragma("unroll") for (int n = 0; n < 2; ++n) _Pragma("unroll") for (int k = 0; k < 2; ++k) \
        acc[ai][bj][m][n] = __builtin_amdgcn_mfma_f32_16x16x32_bf16(Bt[n][k], At[m][k], acc[ai][bj][m][n], 0, 0, 0); __builtin_amdgcn_s_setprio(0); } while (0)
#define PG8_WAIT_V(n) asm volatile("s_waitcnt vmcnt(" #n ")" ::: "memory")
#define PG8_WAIT_L(n) asm volatile("s_waitcnt lgkmcnt(" #n ")" ::: "memory")
#define PG8_BAR __builtin_amdgcn_s_barrier()
#define PG8_SCHED __builtin_amdgcn_sched_barrier(0)
    Unit cur, nxt; int ui = 0;
    if (!S.next(0, cur)) return;
    f32x4 acc[2][2][4][2];
#pragma unroll
    for (int a = 0; a < 2; ++a)
#pragma unroll
        for (int b = 0; b < 2; ++b)
#pragma unroll
            for (int m = 0; m < 4; ++m)
#pragma unroll
                for (int n = 0; n < 2; ++n) acc[a][b][m][n] = (f32x4){0.f, 0.f, 0.f, 0.f};
    bf16x8 At[4][2], B0[2][2], B1[2][2];
    const char* cA = (const char*)g.A + (size_t)cur.pm * tstep; const char* cB = (const char*)g.Bt + (size_t)cur.pn * tstep;
    PG8_STAGE(PG8_SB(0, 0), cB, voffB); PG8_STAGE(PG8_SB(0, 1), cB + hstep, voffB); PG8_STAGE(PG8_SA(0, 0), cA, voffA); PG8_STAGE(PG8_SA(0, 1), cA + hstep, voffA);
    if (wr == 1) PG8_BAR;
    PG8_WAIT_V(2); PG8_BAR;
    PG8_STAGE(PG8_SB(1, 0), cB + kstep, voffB); PG8_STAGE(PG8_SA(1, 0), cA + kstep, voffA); PG8_STAGE(PG8_SB(1, 1), cB + hstep + kstep, voffB);
    PG8_WAIT_V(6); PG8_BAR;
    for (;;) {
        const bool has_next = S.next(ui + 1, nxt);
        const char* nA = has_next ? (const char*)g.A + (size_t)nxt.pm * tstep : cA; const char* nB = has_next ? (const char*)g.Bt + (size_t)nxt.pn * tstep : cB;
        for (int t = 0; t < nt; t += 2) {
            const bool last = (t == nt - 2);
            const char* a1 = cA + (size_t)(t + 1) * kstep;
            const char* a2 = last ? nA : cA + (size_t)(t + 2) * kstep; const char* b2 = last ? nB : cB + (size_t)(t + 2) * kstep;
            const char* a3 = a2 + kstep; const char* b3 = b2 + kstep;
            PG8_LDB(B0, 0, 0); PG8_LDB(B1, 0, 1); PG8_SCHED; PG8_LDA(At, 0, 0); PG8_STAGE(PG8_SA(1, 1), a1 + hstep, voffA);
            PG8_WAIT_V(8); PG8_WAIT_L(0); PG8_BAR; PG8_MMA(0, 0, At, B0); PG8_MMA(0, 1, At, B1); PG8_BAR; PG8_SCHED;
            PG8_LDA(At, 0, 1); PG8_STAGE(PG8_SB(0, 0), b2, voffB); PG8_STAGE(PG8_SB(0, 1), b2 + hstep, voffB); PG8_STAGE(PG8_SA(0, 0), a2, voffA);
            PG8_WAIT_V(8); PG8_WAIT_L(0); PG8_BAR; PG8_MMA(1, 0, At, B0); PG8_MMA(1, 1, At, B1); PG8_BAR; PG8_SCHED;
            PG8_LDB(B0, 1, 0); PG8_LDB(B1, 1, 1); PG8_SCHED; PG8_LDA(At, 1, 0); PG8_STAGE(PG8_SA(0, 1), a2 + hstep, voffA);
            PG8_WAIT_V(8); PG8_WAIT_L(0); PG8_BAR; PG8_MMA(0, 0, At, B0); PG8_MMA(0, 1, At, B1); PG8_BAR; PG8_SCHED;
            PG8_LDA(At, 1, 1); PG8_STAGE(PG8_SB(1, 0), b3, voffB); PG8_STAGE(PG8_SB(1, 1), b3 + hstep, voffB); PG8_STAGE(PG8_SA(1, 0), a3, voffA);
            PG8_WAIT_V(8); PG8_WAIT_L(0); PG8_BAR; PG8_MMA(1, 0, At, B0); PG8_MMA(1, 1, At, B1); PG8_BAR; PG8_SCHED;
        }
        if (wr == 0) PG8_BAR;
        E(acc, cur, ui, wr, wc, fr, fq);
        if (!has_next) break;
        if (!(Epi::PAIRED && (ui & 1) == 0)) {
#pragma unroll
            for (int a = 0; a < 2; ++a)
#pragma unroll
                for (int b = 0; b < 2; ++b)
#pragma unroll
                    for (int m = 0; m < 4; ++m)
#pragma unroll
                        for (int n = 0; n < 2; ++n) acc[a][b][m][n] = (f32x4){0.f, 0.f, 0.f, 0.f};
        }
        cur = nxt; cA = nA; cB = nB; ++ui;
        if (wr == 1) PG8_BAR;
    }
    PG8_WAIT_V(0);
    PG8_BAR;
#undef PG8_SA
#undef PG8_SB
#undef PG8_STAGE
#undef PG8_LDA
#undef PG8_LDB
#undef PG8_MMA
#undef PG8_WAIT_V
#undef PG8_WAIT_L
#undef PG8_BAR
#undef PG8_SCHED
}
}

typedef f32x4 acc_t[2][2][4][2];

struct EpiIn {
    static constexpr bool PERM = true, PAIRED = false;
    unsigned char* ws; bf16_t* Rg; bf16_t* Gg;
    __device__ __forceinline__ void operator()(acc_t& acc, const pg8::Unit& u, int ui, int wr, int wc, int fr, int fq) const {
        const int row0 = u.pm * 256 + wr * 64 + fr; const int pn = u.pn;
        if (pn < 16 || pn == 24) {
            bf16_t* base; int ldc, colt;
            if (pn < 2) { base = (bf16_t*)(ws + Z_Q); ldc = 512; colt = pn * 256; }
            else if (pn < 4) { base = (bf16_t*)(ws + Z_K); ldc = 512; colt = (pn - 2) * 256; }
            else if (pn < 8) { base = (bf16_t*)(ws + Z_V); ldc = 1024; colt = (pn - 4) * 256; }
            else if (pn < 12) { base = (bf16_t*)(ws + Z_G); ldc = 1024; colt = (pn - 8) * 256; }
            else if (pn < 16) { base = (bf16_t*)(ws + Z_CB); ldc = 1024; colt = (pn - 12) * 256; }
            else { base = (bf16_t*)(ws + Z_A); ldc = 256; colt = 0; }
            const int col0 = colt + wc * 32 + 8 * fq;
#pragma unroll
            for (int ai = 0; ai < 2; ++ai)
#pragma unroll
                for (int m = 0; m < 4; ++m) { bf16_t* rowp = base + (size_t)(row0 + ai * 128 + m * 16) * ldc + col0;
#pragma unroll
                    for (int bj = 0; bj < 2; ++bj) { const f32x4 v0 = acc[ai][bj][m][0], v1 = acc[ai][bj][m][1];
                        u32x4 w; w.x = cvt_pk_bf16(v0[0], v0[1]); w.y = cvt_pk_bf16(v0[2], v0[3]); w.z = cvt_pk_bf16(v1[0], v1[1]); w.w = cvt_pk_bf16(v1[2], v1[3]);
                        *(u32x4*)(rowp + bj * 128) = w; } }
        } else if (pn < 24) {
            bf16_t* base = (bf16_t*)(ws + Z_P); const int ch0 = (pn - 16) * 128 + wc * 16 + 4 * fq;
#pragma unroll
            for (int ai = 0; ai < 2; ++ai)
#pragma unroll
                for (int m = 0; m < 4; ++m) { bf16_t* rowp = base + (size_t)(row0 + ai * 128 + m * 16) * 1024 + ch0;
#pragma unroll
                    for (int bj = 0; bj < 2; ++bj) { const f32x4 p = acc[ai][bj][m][0] * acc[ai][bj][m][1];
                        u32x2 w; w.x = cvt_pk_bf16(p[0], p[1]); w.y = cvt_pk_bf16(p[2], p[3]); *(u32x2*)(rowp + bj * 64) = w; } }
        } else {
            const int ch0 = (pn - 25) * 128 + wc * 16 + 4 * fq;
#pragma unroll
            for (int ai = 0; ai < 2; ++ai)
#pragma unroll
                for (int m = 0; m < 4; ++m) { const size_t ro = (size_t)(row0 + ai * 128 + m * 16) * 1024 + ch0;
#pragma unroll
                    for (int bj = 0; bj < 2; ++bj) { const f32x4 ga = acc[ai][bj][m][0], gb = acc[ai][bj][m][1]; float r[4], s[4];
#pragma unroll
                        for (int j = 0; j < 4; ++j) { const float ea = __expf(-ga[j]), eb = __expf(-gb[j]); s[j] = 1.0f / (1.0f + eb); r[j] = (1.0f + eb) / (1.0f + ea); }
                        u32x2 w; w.x = cvt_pk_bf16(r[0], r[1]); w.y = cvt_pk_bf16(r[2], r[3]); *(u32x2*)(Rg + ro + bj * 64) = w;
                        u32x2 x; x.x = cvt_pk_bf16(s[0], s[1]); x.y = cvt_pk_bf16(s[2], s[3]); *(u32x2*)(Gg + ro + bj * 64) = x; } }
        }
    }
};

struct EpiMerge {
    static constexpr bool PERM = true, PAIRED = true;
    const bf16_t* Rg; const bf16_t* Gg; bf16_t* O;
    __device__ __forceinline__ void operator()(acc_t& acc, const pg8::Unit& u, int ui, int wr, int wc, int fr, int fq) const {
        const int second = ui & 1; const int pm = second ? u.pm - 66 : u.pm, pn = second ? u.pn - 4 : u.pn;
        const int row0 = pm * 256 + wr * 64 + fr, col0 = pn * 256 + wc * 32 + 8 * fq;
        const bf16_t* src = second ? Gg : Rg;
#pragma unroll
        for (int ai = 0; ai < 2; ++ai)
#pragma unroll
            for (int m = 0; m < 4; ++m) { const size_t ro = (size_t)(row0 + ai * 128 + m * 16) * 1024 + col0;
#pragma unroll
                for (int bj = 0; bj < 2; ++bj) { const u32x4 f = *(const u32x4*)(src + ro + bj * 128);
                    f32x4 v0 = acc[ai][bj][m][0], v1 = acc[ai][bj][m][1];
                    v0[0] *= bf_lo(f.x); v0[1] *= bf_hi(f.x); v0[2] *= bf_lo(f.y); v0[3] *= bf_hi(f.y);
                    v1[0] *= bf_lo(f.z); v1[1] *= bf_hi(f.z); v1[2] *= bf_lo(f.w); v1[3] *= bf_hi(f.w);
                    if (second) { u32x4 w; w.x = cvt_pk_bf16(v0[0], v0[1]); w.y = cvt_pk_bf16(v0[2], v0[3]); w.z = cvt_pk_bf16(v1[0], v1[1]); w.w = cvt_pk_bf16(v1[2], v1[3]);
                        *(u32x4*)(O + ro + bj * 128) = w; }
                    else { acc[ai][bj][m][0] = v0; acc[ai][bj][m][1] = v1; } } }
    }
};

struct EpiRes {
    static constexpr bool PERM = false, PAIRED = false;
    const float* base0; const float* base1;
    float* out; const float* gate;
    __device__ __forceinline__ void operator()(acc_t& acc, const pg8::Unit& u, int ui, int wr, int wc, int fr, int fq) const {
        const int row0 = u.pm * 256 + wr * 64 + fr, col0 = u.pn * 256 + wc * 32 + 4 * fq;
#pragma unroll
        for (int ai = 0; ai < 2; ++ai)
#pragma unroll
            for (int m = 0; m < 4; ++m) { const int row = row0 + ai * 128 + m * 16;
                const float* bp = (row < MP ? base0 + (size_t)row * 1024 : base1 + (size_t)(row - MP) * 1024) + col0;
                const float* gp = gate + (size_t)modrow_of(row) * NMOD + col0; float* op = out + (size_t)row * 1024 + col0;
#pragma unroll
                for (int bj = 0; bj < 2; ++bj)
#pragma unroll
                    for (int n = 0; n < 2; ++n) { const f32x4 b = *(const f32x4*)(bp + bj * 128 + n * 16), gt = *(const f32x4*)(gp + bj * 128 + n * 16);
                        *(f32x4*)(op + bj * 128 + n * 16) = b + gt * acc[ai][bj][m][n]; }
                asm volatile("" ::: "memory"); }
    }
};

struct EpiAct {
    static constexpr bool PERM = true, PAIRED = false;
    bf16_t* O;
    __device__ __forceinline__ void operator()(acc_t& acc, const pg8::Unit& u, int ui, int wr, int wc, int fr, int fq) const {
        const int row0 = u.pm * 256 + wr * 64 + fr, ch0 = u.pn * 128 + wc * 16 + 4 * fq;
#pragma unroll
        for (int ai = 0; ai < 2; ++ai)
#pragma unroll
            for (int m = 0; m < 4; ++m) { bf16_t* rowp = O + (size_t)(row0 + ai * 128 + m * 16) * DFF + ch0;
#pragma unroll
                for (int bj = 0; bj < 2; ++bj) { const f32x4 gt = acc[ai][bj][m][0], up = acc[ai][bj][m][1]; float a[4];
#pragma unroll
                    for (int j = 0; j < 4; ++j) a[j] = gt[j] * up[j] / (1.0f + __expf(-gt[j]));
                    u32x2 w; w.x = cvt_pk_bf16(a[0], a[1]); w.y = cvt_pk_bf16(a[2], a[3]); *(u32x2*)(rowp + bj * 64) = w; } }
    }
};

__device__ __forceinline__ int pairrow(int idx, int n) { const int tp = idx >> 7, w = idx & 127; return 256 * tp + 32 * (w >> 4) + 8 * ((w >> 2) & 3) + 4 * n + (w & 3); }
__device__ __forceinline__ int map_win(int c) {
    if (c < 3072) return c;
    if (c < 3088) return 6144 + (c - 3072);
    if (c < 4112) return 3072 + (c - 3088);
    if (c < 5136) return 4096 + pairrow(c - 4112, 0);
    if (c < 6160) return 4096 + pairrow(c - 5136, 1);
    if (c < 7184) return 6400 + pairrow(c - 6160, 0);
    return 6400 + pairrow(c - 7184, 1);
}
__device__ __forceinline__ void xpose_tile(LAS unsigned char* lds, const float* src, int Nsrc, int k0, int c0, bf16_t* dst, int dpitch, int mapid) {
    const int tid = threadIdx.x;
    LAS bf16_t* T = (LAS bf16_t*)lds;
#pragma unroll
    for (int i = 0; i < 2; ++i) { const int kr = (tid >> 4) + 32 * i, c4 = (tid & 15) * 4, c = c0 + c4;
        f32x4 v = (f32x4){0.f, 0.f, 0.f, 0.f}; if (c < Nsrc) v = *(const f32x4*)(src + (size_t)(k0 + kr) * Nsrc + c);
#pragma unroll
        for (int j = 0; j < 4; ++j) T[(c4 + j) * 72 + kr] = f2bf(v[j]); }
    __syncthreads();
    { const int cc = tid >> 3, part = tid & 7, c = c0 + cc;
      if (c < Nsrc) { int R = c; if (mapid == 1) R = map_win(c); else if (mapid == 2) R = c < DFF ? pairrow(c, 0) : pairrow(c - DFF, 1);
          *(u32x4*)(dst + (size_t)R * dpitch + k0 + part * 8) = *(const LAS u32x4*)(T + cc * 72 + part * 8); } }
    __syncthreads();
}
__device__ void phase0(const Params& P, LAS unsigned char* lds) {
    const int tid = threadIdx.x, G = gridDim.x;
    unsigned char* ws = P.ws;
    { u32x4* z = (u32x4*)(ws + WS_WIN + (size_t)6160 * 2048); const int n16 = 240 * 2048 / 16;
      for (int i = blockIdx.x * 512 + tid; i < n16; i += G * 512) z[i] = (u32x4){0u, 0u, 0u, 0u}; }
    for (int task = blockIdx.x; task < 5136; task += G) {
        if (task < 2064) { const int kt = task / 129, ct = task % 129; xpose_tile(lds, P.in[9], 8208, kt * 64, ct * 64, (bf16_t*)(ws + WS_WIN), 1024, 1); }
        else if (task < 2320) { const int t = task - 2064; xpose_tile(lds, P.in[13], 1024, (t >> 4) * 64, (t & 15) * 64, (bf16_t*)(ws + WS_WGC), 1024, 0); }
        else if (task < 2576) { const int t = task - 2320; xpose_tile(lds, P.in[16], 1024, (t >> 4) * 64, (t & 15) * 64, (bf16_t*)(ws + WS_WGC) + (size_t)1024 * 1024, 1024, 0); }
        else if (task < 2832) { const int t = task - 2576; xpose_tile(lds, P.in[17], 1024, (t >> 4) * 64, (t & 15) * 64, (bf16_t*)(ws + WS_WO), 1024, 0); }
        else if (task < 4240) { const int t = task - 2832; xpose_tile(lds, P.in[19], 5632, (t / 88) * 64, (t % 88) * 64, (bf16_t*)(ws + WS_WF1), 1024, 2); }
        else if (task < 4944) { const int t = task - 4240; xpose_tile(lds, P.in[20], 1024, (t >> 4) * 64, (t & 15) * 64, (bf16_t*)(ws + WS_WF2), DFF, 0); }
        else {
            const int n0 = (task - 4944) * 32;
            LAS float* CL = (LAS float*)lds; LAS float* RED = (LAS float*)(lds + 81920);
            for (int idx = tid; idx < 20480; idx += 512) { const int r = idx >> 10, k = idx & 1023; CL[idx] = r < 4 ? P.in[2][r * 1024 + k] : P.in[3][(r - 4) * 1024 + k]; }
            __syncthreads();
            const int col = tid & 31, ks = tid >> 5; float a[20];
#pragma unroll
            for (int r = 0; r < 20; ++r) a[r] = 0.f;
            const float* wp = P.in[6] + (size_t)(ks * 64) * NMOD + n0 + col;
            for (int kk = 0; kk < 64; ++kk) { const float w = wp[(size_t)kk * NMOD]; const int k = ks * 64 + kk;
#pragma unroll
                for (int r = 0; r < 20; ++r) a[r] += CL[r * 1024 + k] * w; }
#pragma unroll
            for (int r = 0; r < 20; ++r) RED[(ks * 20 + r) * 32 + col] = a[r];
            __syncthreads();
            for (int o = tid; o < 640; o += 512) { const int r = o >> 5, cc = o & 31; float s = P.in[7][n0 + cc];
                for (int q = 0; q < 16; ++q) s += RED[(q * 20 + r) * 32 + cc];
                ((float*)(ws + WS_MOD))[r * NMOD + n0 + cc] = s; }
            __syncthreads();
        }
    }
}

__device__ void phase_norm_mod(const float* x0, const float* x1, const float* gamma, const float* mod, int sh_off, int sc_off, bf16_t* H) {
    const int lane = threadIdx.x & 63, wid = threadIdx.x >> 6;
    for (int row = blockIdx.x * 8 + wid; row < MTOT; row += gridDim.x * 8) {
        const float* xp = row < MP ? x0 + (size_t)row * 1024 : x1 + (size_t)(row - MP) * 1024;
        f32x4 v[4]; float ss = 0.f;
#pragma unroll
        for (int i = 0; i < 2; ++i) { v[2 * i] = *(const f32x4*)(xp + i * 512 + lane * 8); v[2 * i + 1] = *(const f32x4*)(xp + i * 512 + lane * 8 + 4); }
#pragma unroll
        for (int i = 0; i < 4; ++i) ss += v[i][0] * v[i][0] + v[i][1] * v[i][1] + v[i][2] * v[i][2] + v[i][3] * v[i][3];
#pragma unroll
        for (int o = 32; o >= 1; o >>= 1) ss += __shfl_xor(ss, o);
        const float rstd = rsqrtf(ss * (1.0f / 1024.0f) + EPS);
        const float* mp = mod + (size_t)modrow_of(row) * NMOD;
#pragma unroll
        for (int i = 0; i < 2; ++i) { const int c = i * 512 + lane * 8; float o[8];
#pragma unroll
            for (int hlf = 0; hlf < 2; ++hlf) { const f32x4 g = *(const f32x4*)(gamma + c + 4 * hlf), sc = *(const f32x4*)(mp + sc_off + c + 4 * hlf), sh = *(const f32x4*)(mp + sh_off + c + 4 * hlf);
#pragma unroll
                for (int j = 0; j < 4; ++j) o[4 * hlf + j] = v[2 * i + hlf][j] * rstd * g[j] * (1.0f + sc[j]) + sh[j]; }
            u32x4 w; w.x = cvt_pk_bf16(o[0], o[1]); w.y = cvt_pk_bf16(o[2], o[3]); w.z = cvt_pk_bf16(o[4], o[5]); w.w = cvt_pk_bf16(o[6], o[7]);
            *(u32x4*)(H + (size_t)row * 1024 + c) = w; }
    }
}
__device__ void phase_final_norm(float* x, const float* gamma) {
    const int lane = threadIdx.x & 63, wid = threadIdx.x >> 6;
    for (int row = blockIdx.x * 8 + wid; row < MTOT; row += gridDim.x * 8) {
        float* xp = x + (size_t)row * 1024; f32x4 v[4]; float ss = 0.f;
#pragma unroll
        for (int i = 0; i < 4; ++i) v[i] = *(const f32x4*)(xp + i * 256 + lane * 4);
#pragma unroll
        for (int i = 0; i < 4; ++i) ss += v[i][0] * v[i][0] + v[i][1] * v[i][1] + v[i][2] * v[i][2] + v[i][3] * v[i][3];
#pragma unroll
        for (int o = 32; o >= 1; o >>= 1) ss += __shfl_xor(ss, o);
        const float rstd = rsqrtf(ss * (1.0f / 1024.0f) + EPS);
#pragma unroll
        for (int i = 0; i < 4; ++i) { const f32x4 g = *(const f32x4*)(gamma + i * 256 + lane * 4); *(f32x4*)(xp + i * 256 + lane * 4) = v[i] * rstd * g; }
    }
}

__device__ void conv_block(const Params& P, int blk) {
    const int tid = threadIdx.x, cgp = tid & 127, rg = tid >> 7, c0 = cgp * 8;
    const int row0 = blk * 64 + rg * 16;
    const bf16_t* zp = (const bf16_t*)(P.ws + Z_P); bf16_t* zcb = (bf16_t*)(P.ws + Z_CB);
    int seq0, seqlen; float* cache_out;
    if (row0 < MP) { seq0 = row0 & ~4095; seqlen = 4096; cache_out = P.out + O_CP + (size_t)(row0 >> 12) * 2048; }
    else { const int sb = (row0 - MP) >> 5; seq0 = MP + sb * 32; seqlen = 32; cache_out = P.out + O_CS + (size_t)sb * 2048; }
    float w0[8], w1[8], w2[8], bs[8], p1[8], p2[8];
#pragma unroll
    for (int j = 0; j < 8; ++j) { w0[j] = P.in[14][c0 + j]; w1[j] = P.in[14][1024 + c0 + j]; w2[j] = P.in[14][2048 + c0 + j]; bs[j] = P.in[15][c0 + j]; }
    if (row0 == seq0) {
        if (row0 < MP) {
#pragma unroll
            for (int j = 0; j < 8; ++j) { p1[j] = 0.f; p2[j] = 0.f; }
        } else { const float* cp = P.in[5] + (size_t)((row0 - MP) >> 5) * 2048 + c0;
#pragma unroll
            for (int j = 0; j < 8; ++j) { p2[j] = cp[j]; p1[j] = cp[1024 + j]; } }
    } else {
        const u32x4 a = *(const u32x4*)(zp + (size_t)(row0 - 1) * 1024 + c0), b = *(const u32x4*)(zp + (size_t)(row0 - 2) * 1024 + c0);
        p1[0] = bf_lo(a.x); p1[1] = bf_hi(a.x); p1[2] = bf_lo(a.y); p1[3] = bf_hi(a.y); p1[4] = bf_lo(a.z); p1[5] = bf_hi(a.z); p1[6] = bf_lo(a.w); p1[7] = bf_hi(a.w);
        p2[0] = bf_lo(b.x); p2[1] = bf_hi(b.x); p2[2] = bf_lo(b.y); p2[3] = bf_hi(b.y); p2[4] = bf_lo(b.z); p2[5] = bf_hi(b.z); p2[6] = bf_lo(b.w); p2[7] = bf_hi(b.w);
    }
    for (int i = 0; i < 16; ++i) { const int r = row0 + i;
        const u32x4 a = *(const u32x4*)(zp + (size_t)r * 1024 + c0), b = *(const u32x4*)(zcb + (size_t)r * 1024 + c0);
        float p0[8], cb[8], u[8];
        p0[0] = bf_lo(a.x); p0[1] = bf_hi(a.x); p0[2] = bf_lo(a.y); p0[3] = bf_hi(a.y); p0[4] = bf_lo(a.z); p0[5] = bf_hi(a.z); p0[6] = bf_lo(a.w); p0[7] = bf_hi(a.w);
        cb[0] = bf_lo(b.x); cb[1] = bf_hi(b.x); cb[2] = bf_lo(b.y); cb[3] = bf_hi(b.y); cb[4] = bf_lo(b.z); cb[5] = bf_hi(b.z); cb[6] = bf_lo(b.w); cb[7] = bf_hi(b.w);
#pragma unroll
        for (int j = 0; j < 8; ++j) u[j] = cb[j] * (p2[j] * w0[j] + p1[j] * w1[j] + p0[j] * w2[j] + bs[j]);
        u32x4 w; w.x = cvt_pk_bf16(u[0], u[1]); w.y = cvt_pk_bf16(u[2], u[3]); w.z = cvt_pk_bf16(u[4], u[5]); w.w = cvt_pk_bf16(u[6], u[7]);
        *(u32x4*)(zcb + (size_t)r * 1024 + c0) = w;
        const int pos = r - seq0;
        if (pos >= seqlen - 2) { float* co = cache_out + (size_t)(pos - (seqlen - 2)) * 1024 + c0;
            *(f32x4*)co = (f32x4){p0[0], p0[1], p0[2], p0[3]}; *(f32x4*)(co + 4) = (f32x4){p0[4], p0[5], p0[6], p0[7]}; }
#pragma unroll
        for (int j = 0; j < 8; ++j) { p2[j] = p1[j]; p1[j] = p0[j]; }
    }
}

constexpr int L_QE = 0, L_KE = 17408, L_KLT = 34816, L_VT = 53248, L_SC = 90112, L_AL = 99328, L_PSUM = 103424, L_EDEC = 105472, L_PART = 105984, L_LA = 108032, L_GN = 140800;
#define MFMA32(a, b, c) __builtin_amdgcn_mfma_f32_32x32x16_bf16(a, b, c, 0, 0, 0)

template <bool OUT>
__device__ void gla_walk(const Params& P, LAS unsigned char* lds, int h, int tok0, int nchunks, int nvalid, const float* Sinit, float* Sfinal, float* Dout) {
    const int tid = threadIdx.x, lane = tid & 63, w = __builtin_amdgcn_readfirstlane(tid >> 6), r = lane & 31, hh = lane >> 5;
    const int d = tid & 127, tq = tid >> 7;
    const bf16_t* zq = (const bf16_t*)(P.ws + Z_Q); const bf16_t* zk = (const bf16_t*)(P.ws + Z_K); const bf16_t* zv = (const bf16_t*)(P.ws + Z_V);
    bf16_t* zg = (bf16_t*)(P.ws + Z_G); const bf16_t* za = (const bf16_t*)(P.ws + Z_A);
    LAS bf16_t* QE = (LAS bf16_t*)(lds + L_QE); LAS bf16_t* KE = (LAS bf16_t*)(lds + L_KE); LAS bf16_t* KLT = (LAS bf16_t*)(lds + L_KLT);
    LAS bf16_t* VT = (LAS bf16_t*)(lds + L_VT); LAS bf16_t* SC = (LAS bf16_t*)(lds + L_SC);
    LAS float* AL = (LAS float*)(lds + L_AL); LAS float* PSUM = (LAS float*)(lds + L_PSUM); LAS float* EDEC = (LAS float*)(lds + L_EDEC); LAS float* PART = (LAS float*)(lds + L_PART); LAS float* LA = (LAS float*)(lds + L_LA); LAS float* GN = (LAS float*)(lds + L_GN);

    f32x16 S[4];
#pragma unroll
    for (int db = 0; db < 4; ++db)
#pragma unroll
        for (int g = 0; g < 16; ++g) S[db][g] = 0.f;
    if (Sinit) { const float* sp = Sinit + (size_t)(4 * hh) * 256 + 32 * w + r;
#pragma unroll
        for (int db = 0; db < 4; ++db)
#pragma unroll
            for (int q4 = 0; q4 < 4; ++q4) { const float* p = sp + (size_t)(32 * db + 8 * q4) * 256; asm volatile("" : "+v"(p));
                S[db][4 * q4 + 0] = p[0]; S[db][4 * q4 + 1] = p[256]; S[db][4 * q4 + 2] = p[512]; S[db][4 * q4 + 3] = p[768]; } }
    float wal[16];
#pragma unroll
    for (int q = 0; q < 16; ++q) wal[q] = P.in[10][q * 512 + h * 128 + d];
    const float bal = P.in[11][h * 128 + d];
    if (OUT && tid < 256) GN[tid] = P.in[12][tid];
    float dsum = 0.f;

    for (int ck = 0; ck < nchunks; ++ck, tok0 += 64) {
        { const int idx = tid * 2, t = idx >> 4, rr = idx & 15; unsigned two = 0u; if (t < nvalid) two = *(const unsigned*)(za + (size_t)(tok0 + t) * 256 + rr);
          AL[t * 16 + rr] = bf_lo(two); AL[t * 16 + rr + 1] = bf_hi(two); }
        { const int t = tid >> 3;
#pragma unroll
          for (int i = 0; i < 4; ++i) { const int v8 = (tid & 7) * 8 + 64 * i; u32x4 x = (u32x4){0u, 0u, 0u, 0u};
              if (t < nvalid) x = *(const u32x4*)(zv + (size_t)(tok0 + t) * 1024 + h * 256 + v8);
              VT[(v8 + 0) * 72 + t] = (bf16_t)(x.x & 0xffff); VT[(v8 + 1) * 72 + t] = (bf16_t)(x.x >> 16); VT[(v8 + 2) * 72 + t] = (bf16_t)(x.y & 0xffff); VT[(v8 + 3) * 72 + t] = (bf16_t)(x.y >> 16);
              VT[(v8 + 4) * 72 + t] = (bf16_t)(x.z & 0xffff); VT[(v8 + 5) * 72 + t] = (bf16_t)(x.z >> 16); VT[(v8 + 6) * 72 + t] = (bf16_t)(x.w & 0xffff); VT[(v8 + 7) * 72 + t] = (bf16_t)(x.w >> 16); } }
        __syncthreads();
        float run = 0.f;
#pragma unroll 4
        for (int tt = 0; tt < 16; ++tt) { const int t = 16 * tq + tt; float x = bal;
#pragma unroll
            for (int q = 0; q < 16; ++q) x += AL[t * 16 + q] * wal[q];
            float la = (fminf(x, 0.f) - __logf(1.0f + __expf(-fabsf(x)))) * (1.0f / 16.0f);
            if (t >= nvalid) la = 0.f;
            run += la; LA[t * 128 + d] = run; }
        PSUM[tq * 128 + d] = run;
        __syncthreads();
        float off = 0.f, blast = 0.f;
#pragma unroll
        for (int q = 0; q < 4; ++q) { const float ps = PSUM[q * 128 + d]; blast += ps; if (q < tq) off += ps; }
        if (tq == 0) { EDEC[d] = __expf(blast); dsum += blast; }
        { const bf16_t* kp = zk + (size_t)(tok0 + 16 * tq) * 512 + h * 128 + d; const bf16_t* qp = zq + (size_t)(tok0 + 16 * tq) * 512 + h * 128 + d;
#pragma unroll 1
          for (int t4 = 0; t4 < 16; t4 += 4) { float kk[4], qq[4], bb[4];
#pragma unroll
              for (int j = 0; j < 4; ++j) { const int t = 16 * tq + t4 + j; const bool ok = t < nvalid;
                  kk[j] = ok ? bf2f(kp[(size_t)(t4 + j) * 512]) : 0.f; qq[j] = (OUT && ok) ? bf2f(qp[(size_t)(t4 + j) * 512]) : 0.f; bb[j] = off + LA[t * 128 + d]; }
              *(LAS u32x2*)(KLT + d * 72 + 16 * tq + t4) = (u32x2){cvt_pk_bf16(kk[0] * __expf(blast - bb[0]), kk[1] * __expf(blast - bb[1])), cvt_pk_bf16(kk[2] * __expf(blast - bb[2]), kk[3] * __expf(blast - bb[3]))};
              if (OUT) {
#pragma unroll
                  for (int j = 0; j < 4; ++j) { const int t = 16 * tq + t4 + j;
                      QE[t * 136 + d] = f2bf(qq[j] * 0.08838834764831845f * __expf(bb[j])); KE[t * 136 + d] = f2bf(kk[j] * __expf(-bb[j])); } } } }
        __syncthreads();
        if (OUT) {
            if (w < 3) { const int jb = (w == 2) ? 1 : 0, ib = (w == 0) ? 0 : 1;
                f32x16 a = {0.f, 0.f, 0.f, 0.f, 0.f, 0.f, 0.f, 0.f, 0.f, 0.f, 0.f, 0.f, 0.f, 0.f, 0.f, 0.f};
#pragma unroll
                for (int ks = 0; ks < 8; ++ks) { const bf16x8 A = *(const LAS bf16x8*)(KE + (32 * jb + r) * 136 + 16 * ks + 8 * hh), B = *(const LAS bf16x8*)(QE + (32 * ib + r) * 136 + 16 * ks + 8 * hh);
                    a = MFMA32(A, B, a); }
                const int i = 32 * ib + r;
#pragma unroll
                for (int g = 0; g < 4; ++g) { const int j0 = 32 * jb + 8 * g + 4 * hh; float e[4];
#pragma unroll
                    for (int q = 0; q < 4; ++q) e[q] = (j0 + q <= i) ? a[4 * g + q] : 0.f;
                    *(LAS u32x2*)(SC + i * 72 + j0) = (u32x2){cvt_pk_bf16(e[0], e[1]), cvt_pk_bf16(e[2], e[3])}; }
            } else if (w == 3) {
#pragma unroll
                for (int g = 0; g < 4; ++g) *(LAS u32x2*)(SC + r * 72 + 32 + 8 * g + 4 * hh) = (u32x2){0u, 0u};
            }
            __syncthreads();
        }
        bf16x8 vf[4];
#pragma unroll
        for (int ks = 0; ks < 4; ++ks) vf[ks] = *(const LAS bf16x8*)(VT + (32 * w + r) * 72 + 16 * ks + 8 * hh);
        f32x16 oT[2];
        if (OUT) {
#pragma unroll
            for (int ib = 0; ib < 2; ++ib)
#pragma unroll
                for (int g = 0; g < 16; ++g) oT[ib][g] = 0.f;
#pragma unroll
            for (int db = 0; db < 4; ++db)
#pragma unroll
                for (int s = 0; s < 2; ++s) {
                    u32x4 ap; ap.x = cvt_pk_bf16(S[db][8 * s + 0], S[db][8 * s + 1]); ap.y = cvt_pk_bf16(S[db][8 * s + 2], S[db][8 * s + 3]);
                    ap.z = cvt_pk_bf16(S[db][8 * s + 4], S[db][8 * s + 5]); ap.w = cvt_pk_bf16(S[db][8 * s + 6], S[db][8 * s + 7]);
                    const bf16x8 A = __builtin_bit_cast(bf16x8, ap);
#pragma unroll
                    for (int ib = 0; ib < 2; ++ib) { const int i = 32 * ib + r;
                        const u32x2 lo = *(const LAS u32x2*)(QE + i * 136 + 32 * db + 16 * s + 4 * hh), hi = *(const LAS u32x2*)(QE + i * 136 + 32 * db + 16 * s + 8 + 4 * hh);
                        const u32x4 bp = (u32x4){lo.x, lo.y, hi.x, hi.y};
                        oT[ib] = MFMA32(A, __builtin_bit_cast(bf16x8, bp), oT[ib]); }
                    __builtin_amdgcn_sched_barrier(0); }
#pragma unroll
            for (int ks = 0; ks < 4; ++ks)
#pragma unroll
                for (int ib = 0; ib < 2; ++ib) { const bf16x8 B = *(const LAS bf16x8*)(SC + (32 * ib + r) * 72 + 16 * ks + 8 * hh); oT[ib] = MFMA32(vf[ks], B, oT[ib]); }
            __builtin_amdgcn_sched_barrier(0);
        }
#pragma unroll
        for (int db = 0; db < 4; ++db) {
#pragma unroll
            for (int g = 0; g < 4; ++g) { const f32x4 e = *(const LAS f32x4*)(EDEC + 32 * db + 8 * g + 4 * hh);
                S[db][4 * g + 0] *= e[0]; S[db][4 * g + 1] *= e[1]; S[db][4 * g + 2] *= e[2]; S[db][4 * g + 3] *= e[3]; }
#pragma unroll
            for (int ks = 0; ks < 4; ++ks) { const bf16x8 A = *(const LAS bf16x8*)(KLT + (32 * db + r) * 72 + 16 * ks + 8 * hh); S[db] = MFMA32(A, vf[ks], S[db]); }
            __builtin_amdgcn_sched_barrier(0);
        }
        if (OUT) {
#pragma unroll
            for (int ib = 0; ib < 2; ++ib) { float ss = 0.f;
#pragma unroll
                for (int g = 0; g < 16; ++g) ss += oT[ib][g] * oT[ib][g];
                ss += __shfl_xor(ss, 32);
                if (hh == 0) PART[w * 64 + 32 * ib + r] = ss; }
            __syncthreads();
#pragma unroll
            for (int ib = 0; ib < 2; ++ib) { const int t = 32 * ib + r; float tot = 0.f;
#pragma unroll
                for (int q = 0; q < 8; ++q) tot += PART[q * 64 + t];
                const float rstd = rsqrtf(tot * (1.0f / 256.0f) + EPS);
                if (t < nvalid) { bf16_t* gp = zg + (size_t)(tok0 + t) * 1024 + h * 256 + 32 * w + 4 * hh;
#pragma unroll
                    for (int g = 0; g < 4; ++g) { const u32x2 gg = *(const u32x2*)(gp + 8 * g); const f32x4 gn = *(const LAS f32x4*)(GN + 32 * w + 8 * g + 4 * hh);
                        const float g0 = bf_lo(gg.x), g1 = bf_hi(gg.x), g2 = bf_lo(gg.y), g3 = bf_hi(gg.y);
                        const float o0 = oT[ib][4 * g + 0] * rstd * gn[0] * g0 / (1.0f + __expf(-g0));
                        const float o1 = oT[ib][4 * g + 1] * rstd * gn[1] * g1 / (1.0f + __expf(-g1));
                        const float o2 = oT[ib][4 * g + 2] * rstd * gn[2] * g2 / (1.0f + __expf(-g2));
                        const float o3 = oT[ib][4 * g + 3] * rstd * gn[3] * g3 / (1.0f + __expf(-g3));
                        *(u32x2*)(gp + 8 * g) = (u32x2){cvt_pk_bf16(o0, o1), cvt_pk_bf16(o2, o3)}; } } }
        }
        __syncthreads();
    }
    if (Sfinal) { float* sp = Sfinal + (size_t)(4 * hh) * 256 + 32 * w + r;
#pragma unroll
        for (int db = 0; db < 4; ++db)
#pragma unroll
            for (int q4 = 0; q4 < 4; ++q4) { float* p = sp + (size_t)(32 * db + 8 * q4) * 256; asm volatile("" : "+v"(p));
                p[0] = S[db][4 * q4 + 0]; p[256] = S[db][4 * q4 + 1]; p[512] = S[db][4 * q4 + 2]; p[768] = S[db][4 * q4 + 3]; } }
    if (Dout && tq == 0) Dout[d] = __expf(dsum);
}


#define XB_TMO      128
#define XB_XCNT(j)  (256  + 64 * (j))
#define XB_XSUB(j)  (1280 + 64 * (j))
#define XB_XGEN(j)  (2304 + 64 * (j))
#define XB_TOP      3328
#define XB_TOPGEN   3392
#define XCD_BAR_WORDS 3456
#define XB_SPIN_CAP (1u << 22)
__device__ __forceinline__ unsigned xb_ld(unsigned* p)              { return __hip_atomic_load(p, __ATOMIC_RELAXED, __HIP_MEMORY_SCOPE_AGENT); }
__device__ __forceinline__ unsigned xb_add(unsigned* p, unsigned v) { return __hip_atomic_fetch_add(p, v, __ATOMIC_RELAXED, __HIP_MEMORY_SCOPE_AGENT); }
__device__ __forceinline__ unsigned xb_xcc_id() { return (unsigned)__builtin_amdgcn_s_getreg((3 << 11) | 20) & 0xFu; }
#define XB_SPIN(cond, bar) do { unsigned _sp = 0; while (cond) { __builtin_amdgcn_s_sleep(1); \
    if ((++_sp & 255u) == 0u) { if (xb_ld(&(bar)[XB_TMO])) break; if (_sp > XB_SPIN_CAP) { atomicAdd(&(bar)[XB_TMO], 1u); break; } } } } while (0)
struct XcdBarrier { unsigned* bar; unsigned x; volatile LAS unsigned* st; };
__device__ __forceinline__ XcdBarrier xcd_barrier_post(unsigned* bar, volatile LAS unsigned* st) {
    XcdBarrier b; b.bar = bar; b.x = xb_xcc_id(); b.st = st;
    if (threadIdx.x == 0) (void)xb_add(&bar[XB_XCNT(b.x)], 1u);
    return b;
}
__device__ __forceinline__ void xcd_barrier_complete(unsigned* bar, unsigned x, unsigned& nloc, unsigned& nx) {
    const unsigned G = gridDim.x * gridDim.y * gridDim.z;
    unsigned sum, cnt, mine, sp = 0u;
    for (;;) {
        sum = 0u; cnt = 0u; mine = 0u;
#pragma unroll
        for (unsigned j = 0; j < 16; ++j) { const unsigned c = xb_ld(&bar[XB_XCNT(j)]); sum += c; cnt += (c > 0u) ? 1u : 0u; mine = (j == x) ? c : mine; }
        if (sum == G) break;
        __builtin_amdgcn_s_sleep(1);
        if ((++sp & 255u) == 0u) { if (xb_ld(&bar[XB_TMO])) break; if (sp > XB_SPIN_CAP) { atomicAdd(&bar[XB_TMO], 1u); break; } }
    }
    nloc = mine > 0u ? mine : 1u; nx = cnt > 0u ? cnt : 1u;
}
__device__ __forceinline__ void xcd_barrier(const XcdBarrier& b) {
    asm volatile("s_waitcnt vmcnt(0)" ::: "memory");
    __syncthreads();
    if (threadIdx.x == 0) {
        unsigned* bar = b.bar;
        __builtin_amdgcn_s_waitcnt(0);
        unsigned nloc = b.st[0], nx = b.st[1];
        if (nloc == 0u) { xcd_barrier_complete(bar, b.x, nloc, nx); b.st[0] = nloc; b.st[1] = nx; }
        const unsigned old = xb_add(&bar[XB_XSUB(b.x)], 1u);
        const unsigned gen = old / nloc;
        if (old + 1u == (gen + 1u) * nloc) {
            __builtin_amdgcn_fence(__ATOMIC_RELEASE, "agent");
            asm volatile("s_waitcnt vmcnt(0)" ::: "memory");
            const unsigned og = xb_add(&bar[XB_TOP], 1u);
            const unsigned tg = og / nx;
            if (og + 1u == (tg + 1u) * nx) xb_add(&bar[XB_TOPGEN], 1u);
            else XB_SPIN(xb_ld(&bar[XB_TOPGEN]) == tg, bar);
            __builtin_amdgcn_fence(__ATOMIC_ACQUIRE, "agent");
            xb_add(&bar[XB_XGEN(b.x)], 1u);
            asm volatile("s_waitcnt vmcnt(0)" ::: "memory");
        } else {
            XB_SPIN(xb_ld(&bar[XB_XGEN(b.x)]) == gen, bar);
            __builtin_amdgcn_fence(__ATOMIC_ACQUIRE, "agent");
            asm volatile("s_waitcnt vmcnt(0)" ::: "memory");
        }
    }
    __syncthreads();
}

__global__ void __launch_bounds__(512, 2) fwd_megakernel(Params P) {
    extern __shared__ __attribute__((aligned(16))) unsigned char lds_raw[];
    LAS unsigned char* lds = (LAS unsigned char*)lds_raw;
    cg::grid_group grid = cg::this_grid();
    const int G = gridDim.x, bid = blockIdx.x, tid = threadIdx.x;
    unsigned char* ws = P.ws;
    float* mod = (float*)(ws + WS_MOD);
    bf16_t* Hb = (bf16_t*)(ws + WS_H);
    bf16_t* Rg = (bf16_t*)P.out;
    bf16_t* Gg = Rg + (size_t)MTOT * 1024;
    volatile LAS unsigned* xst = (volatile LAS unsigned*)(lds + LDS_BYTES - 16);
    if (tid < 4) xst[tid] = 0u;
    __syncthreads();
    const XcdBarrier xbar = xcd_barrier_post((unsigned*)(ws + WS_BAR), xst);
    if (P.ws == nullptr) grid.sync();
#define GRID_SYNC() xcd_barrier(xbar)

#ifndef PHMASK
#define PHMASK 0xffff
#endif
#define PH(n) if ((PHMASK >> (n)) & 1)
    PH(0) phase0(P, lds);
    if (PROBE_P0) { __syncthreads(); phase0(P, lds); }
    for (int q = 0; q < PROBE_SYNC; ++q) GRID_SYNC();
    GRID_SYNC();
    PH(1) phase_norm_mod(P.in[0], P.in[1], P.in[8], mod, 0, 1024, Hb);
    if (PROBE_NORM) phase_norm_mod(P.in[0], P.in[1], P.in[8], mod, 0, 1024, Hb);
    GRID_SYNC();
    PH(2) { pg8::Gemm g{Hb, (const bf16_t*)(ws + WS_WIN), 1024}; pg8::Order S; S.init(66, 33, G, bid);
      EpiIn E{ws, Rg, Gg}; pg8::gemm_phase<EpiIn>(lds, g, S, E); if (PROBE_DUP) pg8::gemm_phase<EpiIn>(lds, g, S, E); }
    GRID_SYNC();
    if (PROBE_GLA1) for (int it = bid; it < 240; it += G) { const int bh = it / 15, seg = it % 15, b = bh >> 2, h = bh & 3;
            gla_walk<false>(P, lds, h, b * 4096 + seg * (SEGCH * 64), SEGCH, 64, nullptr, (float*)(ws + SEG_STATE) + (size_t)(bh * 16 + seg) * 32768, (float*)(ws + SEG_DEC) + (size_t)(bh * 16 + seg) * 128); }
    PH(3) for (int it = bid; it < 304; it += G) {
        if (it < 240) { const int bh = it / 15, seg = it % 15, b = bh >> 2, h = bh & 3;
            gla_walk<false>(P, lds, h, b * 4096 + seg * (SEGCH * 64), SEGCH, 64, nullptr, (float*)(ws + SEG_STATE) + (size_t)(bh * 16 + seg) * 32768, (float*)(ws + SEG_DEC) + (size_t)(bh * 16 + seg) * 128);
        } else { const int sbh = it - 240, sb = sbh >> 2, h = sbh & 3;
            gla_walk<true>(P, lds, h, MP + sb * 32, 1, 32, P.in[4] + (size_t)sbh * 32768, P.out + O_SS + (size_t)sbh * 32768, nullptr); }
    }
    PH(4) for (int blk = bid; blk < 264; blk += G) conv_block(P, blk);
    GRID_SYNC();
    for (int e4 = bid * 512 + tid; e4 < 16 * 8192; e4 += G * 512) { const int bh = e4 >> 13, idx = (e4 & 8191) * 4, dd = idx >> 8;
        f32x4 s = (f32x4){0.f, 0.f, 0.f, 0.f};
        for (int seg = 0; seg < 15; ++seg) { float* lp = (float*)(ws + SEG_STATE) + (size_t)(bh * 16 + seg) * 32768 + idx;
            const float dc = ((const float*)(ws + SEG_DEC))[(bh * 16 + seg) * 128 + dd];
            s = s * dc + *(const f32x4*)lp; *(f32x4*)lp = s; } }
    GRID_SYNC();
    PH(5) for (int it = bid; it < 256; it += G) { const int bh = it >> 4, seg = it & 15, b = bh >> 2, h = bh & 3;
        gla_walk<true>(P, lds, h, b * 4096 + seg * (SEGCH * 64), SEGCH, 64, seg ? (const float*)(ws + SEG_STATE) + (size_t)(bh * 16 + seg - 1) * 32768 : nullptr,
                       seg == 15 ? P.out + O_SP + (size_t)bh * 32768 : nullptr, nullptr); }
    GRID_SYNC();
    PH(6) { pg8::Gemm g{(const bf16_t*)(ws + Z_G), (const bf16_t*)(ws + WS_WGC), 1024}; pg8::Order S; S.init(66, 4, G, bid, 1, 66, 4);
      EpiMerge E{Rg, Gg, (bf16_t*)(ws + Z_V)}; pg8::gemm_phase<EpiMerge>(lds, g, S, E); if (PROBE_DUP) pg8::gemm_phase<EpiMerge>(lds, g, S, E); }
    GRID_SYNC();
    PH(7) { pg8::Gemm g{(const bf16_t*)(ws + Z_V), (const bf16_t*)(ws + WS_WO), 1024}; pg8::Order S; S.init(66, 4, G, bid);
      EpiRes E{P.in[0], P.in[1], P.out, mod + 2048}; pg8::gemm_phase<EpiRes>(lds, g, S, E); if (PROBE_DUP) pg8::gemm_phase<EpiRes>(lds, g, S, E); }
    GRID_SYNC();
    PH(8) phase_norm_mod(P.out, P.out + (size_t)MP * 1024, P.in[18], mod, 3072, 4096, Hb);
    GRID_SYNC();
    PH(9) { pg8::Gemm g{Hb, (const bf16_t*)(ws + WS_WF1), 1024}; pg8::Order S; S.init(66, 22, G, bid);
      EpiAct E{(bf16_t*)(ws + WS_Z)}; pg8::gemm_phase<EpiAct>(lds, g, S, E); if (PROBE_DUP) pg8::gemm_phase<EpiAct>(lds, g, S, E); }
    GRID_SYNC();
    PH(10) { pg8::Gemm g{(const bf16_t*)(ws + WS_Z), (const bf16_t*)(ws + WS_WF2), DFF}; pg8::Order S; S.init(66, 4, G, bid);
      EpiRes E{P.out, P.out + (size_t)MP * 1024, P.out, mod + 5120}; pg8::gemm_phase<EpiRes>(lds, g, S, E); }
    GRID_SYNC();
    PH(11) phase_final_norm(P.out, P.in[21]);
}

extern "C" void kernel_launch(void* const* d_in, const int* in_sizes, int n_in, void* d_out, int out_size, void* d_ws, size_t ws_size, hipStream_t stream) {
    static int grid_blocks = 0;
    if (grid_blocks == 0) {
        if (n_in != 22 || ws_size < WS_END) { fprintf(stderr, "kernel_launch: unexpected n_in %d / ws %zu (need %zu)\n", n_in, ws_size, (size_t)WS_END); grid_blocks = -1; return; }
        int dev = 0, cus = 0, per_cu = 0;
        hipGetDevice(&dev); hipDeviceGetAttribute(&cus, hipDeviceAttributeMultiprocessorCount, dev);
        if (hipFuncSetAttribute((const void*)fwd_megakernel, hipFuncAttributeMaxDynamicSharedMemorySize, LDS_BYTES) != hipSuccess) { fprintf(stderr, "kernel_launch: hipFuncSetAttribute failed\n"); grid_blocks = -1; return; }
        hipOccupancyMaxActiveBlocksPerMultiprocessor(&per_cu, (const void*)fwd_megakernel, 512, LDS_BYTES);
        (void)hipGetLastError();
        if (per_cu < 1) per_cu = 1;
        grid_blocks = cus;
        fprintf(stderr, "kernel_launch: cus %d per_cu %d grid %d\n", cus, per_cu, grid_blocks);
    }
    if (grid_blocks < 0) return;
    if (hipMemsetAsync((char*)d_ws + WS_BAR, 0, 16384, stream) != hipSuccess) { fprintf(stderr, "kernel_launch: memset failed\n"); return; }
    Params p{};
    for (int i = 0; i < 22; ++i) p.in[i] = (const float*)d_in[i];
    p.out = (float*)d_out; p.ws = (unsigned char*)d_ws;
    void* args[] = {&p};
    hipError_t e = hipLaunchCooperativeKernel((const void*)fwd_megakernel, dim3(grid_blocks), dim3(512), args, LDS_BYTES, stream);
    if (e != hipSuccess) fprintf(stderr, "cooperative launch failed: %s (grid %d)\n", hipGetErrorString(e), grid_blocks);
}
```

```cpp
#include <hip/hip_runtime.h>
#include <hip/hip_cooperative_groups.h>
#include <cstdio>
#include <cstdint>
namespace cg = cooperative_groups;

#define LAS __attribute__((address_space(3)))
typedef unsigned short bf16_t;
typedef short bf16x8 __attribute__((ext_vector_type(8)));
typedef float f32x4 __attribute__((ext_vector_type(4)));
typedef float f32x16 __attribute__((ext_vector_type(16)));
typedef unsigned u32x4 __attribute__((ext_vector_type(4)));
typedef unsigned u32x2 __attribute__((ext_vector_type(2)));

constexpr int DM = 1024, MP = 16384, MTOT = 16896, NMODROW = 20, NMOD = 6144;
constexpr int NIN = 8448;
constexpr int DFF = 2816;
constexpr int NSEG = 16, SEGCH = 4;
constexpr float EPS = 1e-6f;

constexpr size_t WS_WIN = 0;
constexpr size_t WS_WGC = WS_WIN + (size_t)NIN * 1024 * 2;
constexpr size_t WS_WO  = WS_WGC + (size_t)2 * 1024 * 1024 * 2;
constexpr size_t WS_WF1 = WS_WO + (size_t)1024 * 1024 * 2;
constexpr size_t WS_WF2 = WS_WF1 + (size_t)5632 * 1024 * 2;
constexpr size_t WS_MOD = WS_WF2 + (size_t)1024 * 2816 * 2;
constexpr size_t WS_H   = WS_MOD + (size_t)NMODROW * NMOD * 4;
constexpr size_t WS_Z   = WS_H + (size_t)MTOT * 1024 * 2;
constexpr size_t Z_Q = WS_Z;
constexpr size_t Z_K = Z_Q + (size_t)MTOT * 512 * 2;
constexpr size_t Z_V = Z_K + (size_t)MTOT * 512 * 2;
constexpr size_t Z_G = Z_V + (size_t)MTOT * 1024 * 2;
constexpr size_t Z_CB = Z_G + (size_t)MTOT * 1024 * 2;
constexpr size_t Z_P = Z_CB + (size_t)MTOT * 1024 * 2;
constexpr size_t Z_A = Z_P + (size_t)MTOT * 1024 * 2;
constexpr size_t WS_BAR = Z_A + (size_t)MTOT * 256 * 2;
constexpr size_t WS_END = WS_BAR + 16384;
constexpr size_t SEG_STATE = WS_H;
constexpr size_t SEG_DEC = WS_H + (size_t)16 * 16 * 32768 * 4;
static_assert(SEG_DEC + 16 * 16 * 128 * 4 <= WS_Z, "seg state fits in H");
static_assert(WS_END <= (size_t)256 * 1024 * 1024, "ws");
constexpr size_t O_Y = 0, O_SP = 17301504, O_CP = 17825792, O_SS = 17833984, O_CS = 19931136;

constexpr int LDS_BYTES = 144 * 1024;
#ifndef PROBE_DUP
#define PROBE_DUP 0
#endif
#ifndef PROBE_P0
#define PROBE_P0 0
#endif
#ifndef PROBE_NORM
#define PROBE_NORM 0
#endif
#ifndef PROBE_GLA1
#define PROBE_GLA1 0
#endif
#ifndef PROBE_SYNC
#define PROBE_SYNC 0
#endif

struct Params { const float* in[22]; float* out; unsigned char* ws; };

__device__ __forceinline__ unsigned cvt_pk_bf16(float lo, float hi) { unsigned r; asm("v_cvt_pk_bf16_f32 %0, %1, %2" : "=v"(r) : "v"(lo), "v"(hi)); return r; }
__device__ __forceinline__ float bf_lo(unsigned w) { return __uint_as_float(w << 16); }
__device__ __forceinline__ float bf_hi(unsigned w) { return __uint_as_float(w & 0xffff0000u); }
__device__ __forceinline__ float bf2f(bf16_t b) { return __uint_as_float(((unsigned)b) << 16); }
__device__ __forceinline__ bf16_t f2bf(float f) { return (bf16_t)(cvt_pk_bf16(f, 0.f) & 0xffffu); }
__device__ __forceinline__ float sigmoidf_(float x) { return 1.0f / (1.0f + __expf(-x)); }
__device__ __forceinline__ int modrow_of(int row) { return row < MP ? (row >> 12) : 4 + ((row - MP) >> 5); }

namespace pg8 {
constexpr int BM = 256, BK = 64, HALF = 128, HTB = HALF * BK * 2, STAGE_BYTES = 8 * HTB, NXCD = 8, WGM = 8;
__host__ __device__ __forceinline__ int lds_byte(int r, int c) { const int st = (r >> 4) * 2 + (c >> 5), rr = r & 15, cc = c & 31, ob = rr * 64 + cc * 2; return st * 1024 + (ob ^ (((ob >> 9) & 1) << 5)); }
__host__ __device__ __forceinline__ void stage_rc(int b, int& R, int& C) { const int st = b / 1024, sb = b % 1024, swz = sb ^ (((sb >> 9) & 1) << 5); R = (st >> 1) * 16 + swz / 64; C = (st & 1) * 32 + (swz % 64) / 2; }
__host__ __device__ __forceinline__ int perm32(int rho) { const int n = rho >> 4, i = rho & 15; return 8 * (i >> 2) + 4 * n + (i & 3); }

struct Unit { int pm, pn; };
struct Gemm { const bf16_t* A; const bf16_t* Bt; int K; };

struct Order {
    int nM, nN, nwg, G, c, paired, dpm, dpn;
    __device__ void init(int nM_, int nN_, int G_, int c_, int paired_ = 0, int dpm_ = 0, int dpn_ = 0) { nM = nM_; nN = nN_; nwg = nM * nN; G = G_; c = c_; paired = paired_; dpm = dpm_; dpn = dpn_; }
    __device__ bool next(int i, Unit& u) const {
        const int it = paired ? (i >> 1) : i;
        const long L = (long)it * G + c; if (L >= nwg) return false;
        int wgid = (int)L; { const int q = nwg / NXCD, r = nwg % NXCD, xcd = wgid % NXCD, off = wgid / NXCD; wgid = (xcd < r ? xcd * (q + 1) : r * (q + 1) + (xcd - r) * q) + off; }
        const int nig = WGM * nN, gid = wgid / nig, fm = gid * WGM, gsz = (nM - fm) < WGM ? (nM - fm) : WGM;
        u.pm = fm + ((wgid % nig) % gsz); u.pn = (wgid % nig) / gsz;
        if (paired && (i & 1)) { u.pm += dpm; u.pn += dpn; }
        return true;
    }
};

template <class Epi>
__device__ __forceinline__ void gemm_phase(LAS unsigned char* lds, const Gemm g, const Order& S, const Epi& E) {
    const int tid = threadIdx.x, wid = __builtin_amdgcn_readfirstlane(tid >> 6), lane = tid & 63, wr = wid >> 2, wc = wid & 3, fr = lane & 15, fq = lane >> 4;
    const int K = g.K, nt = K / BK;
    unsigned voffA[2], voffB[2];
#pragma unroll
    for (int i = 0; i < 2; ++i) { int R, C; stage_rc(tid * 16 + i * 8192, R, C); const int Rb = Epi::PERM ? ((R & ~31) + perm32(R & 31)) : R;
        voffA[i] = (unsigned)(R * K + C) * 2u; voffB[i] = (unsigned)(Rb * K + C) * 2u; }
    const size_t kstep = (size_t)(BK * 2);
    const size_t hstep = (size_t)HALF * K * 2;
    const size_t tstep = 2 * hstep;
    const unsigned ldsw = (unsigned)wid * 1024u;
    const int aoff = lds_byte(wr * 64 + fr, fq * 8), boff = lds_byte(wc * 32 + fr, fq * 8);
#define PG8_SA(b, h) (((b) * 2 + (h)) * HTB)
#define PG8_SB(b, h) ((4 + (b) * 2 + (h)) * HTB)
#define PG8_STAGE(bufoff, gbase, voff) do { _Pragma("unroll") for (int _i = 0; _i < 2; ++_i) \
        __builtin_amdgcn_global_load_lds((const unsigned*)((const char*)(gbase) + (voff)[_i]), (LAS unsigned*)(lds + (bufoff) + ldsw + _i * 8192), 16, 0, 0); } while (0)
#define PG8_LDA(dst, b, h) do { _Pragma("unroll") for (int m = 0; m < 4; ++m) _Pragma("unroll") for (int k = 0; k < 2; ++k) dst[m][k] = *(const LAS bf16x8*)(lds + PG8_SA(b, h) + aoff + m * 2048 + k * 1024); } while (0)
#define PG8_LDB(dst, b, h) do { _Pragma("unroll") for (int n = 0; n < 2; ++n) _Pragma("unroll") for (int k = 0; k < 2; ++k) dst[n][k] = *(const LAS bf16x8*)(lds + PG8_SB(b, h) + boff + n * 2048 + k * 1024); } while (0)
#define PG8_MMA(ai, bj, At, Bt) do { __builtin_amdgcn_s_setprio(1); _Pragma("unroll") for (int m = 0; m < 4; ++m) _Pragma("unroll") for (int n = 0; n < 2; ++n) _Pragma("unroll") for (int k = 0; k < 2; ++k) \
        acc[ai][bj][m][n] = __builtin_amdgcn_mfma_f32_16x16x32_bf16(Bt[n][k], At[m][k], acc[ai][bj][m][n], 0, 0, 0); __builtin_amdgcn_s_setprio(0); } while (0)
#define PG8_WAIT_V(n) asm volatile("s_waitcnt vmcnt(" #n ")" ::: "memory")
#define PG8_WAIT_L(n) asm volatile("s_waitcnt lgkmcnt(" #n ")" ::: "memory")
#define PG8_BAR __builtin_amdgcn_s_barrier()
#define PG8_SCHED __builtin_amdgcn_sched_barrier(0)
    Unit cur, nxt; int ui = 0;
    if (!S.next(0, cur)) return;
    f32x4 acc[2][2][4][2];
#pragma unroll
    for (int a = 0; a < 2; ++a)
#pragma unroll
        for (int b = 0; b < 2; ++b)
#pragma unroll
            for (int m = 0; m < 4; ++m)
#pragma unroll
                for (int n = 0; n < 2; ++n) acc[a][b][m][n] = (f32x4){0.f, 0.f, 0.f, 0.f};
    bf16x8 At[4][2], B0[2][2], B1[2][2];
    const char* cA = (const char*)g.A + (size_t)cur.pm * tstep; const char* cB = (const char*)g.Bt + (size_t)cur.pn * tstep;
    PG8_STAGE(PG8_SB(0, 0), cB, voffB); PG8_STAGE(PG8_SB(0, 1), cB + hstep, voffB); PG8_STAGE(PG8_SA(0, 0), cA, voffA); PG8_STAGE(PG8_SA(0, 1), cA + hstep, voffA);
    if (wr == 1) PG8_BAR;
    PG8_WAIT_V(2); PG8_BAR;
    PG8_STAGE(PG8_SB(1, 0), cB + kstep, voffB); PG8_STAGE(PG8_SA(1, 0), cA + kstep, voffA); PG8_STAGE(PG8_SB(1, 1), cB + hstep + kstep, voffB);
    PG8_WAIT_V(6); PG8_BAR;
    for (;;) {
        const bool has_next = S.next(ui + 1, nxt);
        const char* nA = has_next ? (const char*)g.A + (size_t)nxt.pm * tstep : cA; const char* nB = has_next ? (const char*)g.Bt + (size_t)nxt.pn * tstep : cB;
        for (int t = 0; t < nt; t += 2) {
            const bool last = (t == nt - 2);
            const char* a1 = cA + (size_t)(t + 1) * kstep;
            const char* a2 = last ? nA : cA + (size_t)(t + 2) * kstep; const char* b2 = last ? nB : cB + (size_t)(t + 2) * kstep;
            const char* a3 = a2 + kstep; const char* b3 = b2 + kstep;
            PG8_LDB(B0, 0, 0); PG8_LDB(B1, 0, 1); PG8_SCHED; PG8_LDA(At, 0, 0); PG8_STAGE(PG8_SA(1, 1), a1 + hstep, voffA);
            PG8_WAIT_V(8); PG8_WAIT_L(0); PG8_BAR; PG8_MMA(0, 0, At, B0); PG8_MMA(0, 1, At, B1); PG8_BAR; PG8_SCHED;
            PG8_LDA(At, 0, 1); PG8_STAGE(PG8_SB(0, 0), b2, voffB); PG8_STAGE(PG8_SB(0, 1), b2 + hstep, voffB); PG8_STAGE(PG8_SA(0, 0), a2, voffA);
            PG8_WAIT_V(8); PG8_WAIT_L(0); PG8_BAR; PG8_MMA(1, 0, At, B0); PG8_MMA(1, 1, At, B1); PG8_BAR; PG8_SCHED;
            PG8_LDB(B0, 1, 0); PG8_LDB(B1, 1, 1); PG8_SCHED; PG8_LDA(At, 1, 0); PG8_STAGE(PG8_SA(0, 1), a2 + hstep, voffA);
            PG8_WAIT_V(8); PG8_WAIT_L(0); PG8_BAR; PG8_MMA(0, 0, At, B0); PG8_MMA(0, 1, At, B1); PG8_BAR; PG8_SCHED;
            PG8_LDA(At, 1, 1); PG8_STAGE(PG8_SB(1, 0), b3, voffB); PG8_STAGE(PG8_SB(1, 1), b3 + hstep, voffB); PG8_STAGE(PG8_SA(1, 0), a3, voffA);
            PG8_WAIT_V(8); PG8_WAIT_L(0); PG8_BAR; PG8_MMA(1, 0, At, B0); PG8_MMA(1, 1, At, B1); PG8_BAR; PG8_SCHED;
        }
        if (wr == 0) PG8_BAR;
        E(acc, cur, ui, wr, wc, fr, fq);
        if (!has_next) break;
        if (!(Epi::PAIRED && (ui & 1) == 0)) {
#pragma unroll
            for (int a = 0; a < 2; ++a)
#pragma unroll
                for (int b = 0; b < 2; ++b)
#pragma unroll
                    for (int m = 0; m < 4; ++m)
#pragma unroll
                        for (int n = 0; n < 2; ++n) acc[a][b][m][n] = (f32x4){0.f, 0.f, 0.f, 0.f};
        }
        cur = nxt; cA = nA; cB = nB; ++ui;
        if (wr == 1) PG8_BAR;
    }
    PG8_WAIT_V(0);
    PG8_BAR;
#undef PG8_SA
#undef PG8_SB
#undef PG8_STAGE
#undef PG8_LDA
#undef PG8_LDB
#undef PG8_MMA
#undef PG8_WAIT_V
#undef PG8_WAIT_L
#undef PG8_BAR
#undef PG8_SCHED
}
}

typedef f32x4 acc_t[2][2][4][2];

struct EpiIn {
    static constexpr bool PERM = true, PAIRED = false;
    unsigned char* ws; bf16_t* Rg; bf16_t* Gg;
    __device__ __forceinline__ void operator()(acc_t& acc, const pg8::Unit& u, int ui, int wr, int wc, int fr, int fq) const {
        const int row0 = u.pm * 256 + wr * 64 + fr; const int pn = u.pn;
        if (pn < 16 || pn == 24) {
            bf16_t* base; int ldc, colt;
            if (pn < 2) { base = (bf16_t*)(ws + Z_Q); ldc = 512; colt = pn * 256; }
            else if (pn < 4) { base = (bf16_t*)(ws + Z_K); ldc = 512; colt = (pn - 2) * 256; }
            else if (pn < 8) { base = (bf16_t*)(ws + Z_V); ldc = 1024; colt = (pn - 4) * 256; }
            else if (pn < 12) { base = (bf16_t*)(ws + Z_G); ldc = 1024; colt = (pn - 8) * 256; }
            else if (pn < 16) { base = (bf16_t*)(ws + Z_CB); ldc = 1024; colt = (pn - 12) * 256; }
            else { base = (bf16_t*)(ws + Z_A); ldc = 256; colt = 0; }
            const int col0 = colt + wc * 32 + 8 * fq;
#pragma unroll
            for (int ai = 0; ai < 2; ++ai)
#pragma unroll
                for (int m = 0; m < 4; ++m) { bf16_t* rowp = base + (size_t)(row0 + ai * 128 + m * 16) * ldc + col0;
#pragma unroll
                    for (int bj = 0; bj < 2; ++bj) { const f32x4 v0 = acc[ai][bj][m][0], v1 = acc[ai][bj][m][1];
                        u32x4 w; w.x = cvt_pk_bf16(v0[0], v0[1]); w.y = cvt_pk_bf16(v0[2], v0[3]); w.z = cvt_pk_bf16(v1[0], v1[1]); w.w = cvt_pk_bf16(v1[2], v1[3]);
                        *(u32x4*)(rowp + bj * 128) = w; } }
        } else if (pn < 24) {
            bf16_t* base = (bf16_t*)(ws + Z_P); const int ch0 = (pn - 16) * 128 + wc * 16 + 4 * fq;
#pragma unroll
            for (int ai = 0; ai < 2; ++ai)
#pragma unroll
                for (int m = 0; m < 4; ++m) { bf16_t* rowp = base + (size_t)(row0 + ai * 128 + m * 16) * 1024 + ch0;
#pragma unroll
                    for (int bj = 0; bj < 2; ++bj) { const f32x4 p = acc[ai][bj][m][0] * acc[ai][bj][m][1];
                        u32x2 w; w.x = cvt_pk_bf16(p[0], p[1]); w.y = cvt_pk_bf16(p[2], p[3]); *(u32x2*)(rowp + bj * 64) = w; } }
        } else {
            const int ch0 = (pn - 25) * 128 + wc * 16 + 4 * fq;
#pragma unroll
            for (int ai = 0; ai < 2; ++ai)
#pragma unroll
                for (int m = 0; m < 4; ++m) { const size_t ro = (size_t)(row0 + ai * 128 + m * 16) * 1024 + ch0;
#pragma unroll
                    for (int bj = 0; bj < 2; ++bj) { const f32x4 ga = acc[ai][bj][m][0], gb = acc[ai][bj][m][1]; float r[4], s[4];
#pragma unroll
                        for (int j = 0; j < 4; ++j) { const float ea = __expf(-ga[j]), eb = __expf(-gb[j]); s[j] = 1.0f / (1.0f + eb); r[j] = (1.0f + eb) / (1.0f + ea); }
                        u32x2 w; w.x = cvt_pk_bf16(r[0], r[1]); w.y = cvt_pk_bf16(r[2], r[3]); *(u32x2*)(Rg + ro + bj * 64) = w;
                        u32x2 x; x.x = cvt_pk_bf16(s[0], s[1]); x.y = cvt_pk_bf16(s[2], s[3]); *(u32x2*)(Gg + ro + bj * 64) = x; } }
        }
    }
};

struct EpiMerge {
    static constexpr bool PERM = true, PAIRED = true;
    const bf16_t* Rg; const bf16_t* Gg; bf16_t* O;
    __device__ __forceinline__ void operator()(acc_t& acc, const pg8::Unit& u, int ui, int wr, int wc, int fr, int fq) const {
        const int second = ui & 1; const int pm = second ? u.pm - 66 : u.pm, pn = second ? u.pn - 4 : u.pn;
        const int row0 = pm * 256 + wr * 64 + fr, col0 = pn * 256 + wc * 32 + 8 * fq;
        const bf16_t* src = second ? Gg : Rg;
#pragma unroll
        for (int ai = 0; ai < 2; ++ai)
#pragma unroll
            for (int m = 0; m < 4; ++m) { const size_t ro = (size_t)(row0 + ai * 128 + m * 16) * 1024 + col0;
#pragma unroll
                for (int bj = 0; bj < 2; ++bj) { const u32x4 f = *(const u32x4*)(src + ro + bj * 128);
                    f32x4 v0 = acc[ai][bj][m][0], v1 = acc[ai][bj][m][1];
                    v0[0] *= bf_lo(f.x); v0[1] *= bf_hi(f.x); v0[2] *= bf_lo(f.y); v0[3] *= bf_hi(f.y);
                    v1[0] *= bf_lo(f.z); v1[1] *= bf_hi(f.z); v1[2] *= bf_lo(f.w); v1[3] *= bf_hi(f.w);
                    if (second) { u32x4 w; w.x = cvt_pk_bf16(v0[0], v0[1]); w.y = cvt_pk_bf16(v0[2], v0[3]); w.z = cvt_pk_bf16(v1[0], v1[1]); w.w = cvt_pk_bf16(v1[2], v1[3]);
                        *(u32x4*)(O + ro + bj * 128) = w; }
                    else { acc[ai][bj][m][0] = v0; acc[ai][bj][m][1] = v1; } } }
    }
};

struct EpiRes {
    static constexpr bool PERM = false, PAIRED = false;
    const float* base0; const float* base1;
    float* out; const float* gate;
    __device__ __forceinline__ void operator()(acc_t& acc, const pg8::Unit& u, int ui, int wr, int wc, int fr, int fq) const {
        const int row0 = u.pm * 256 + wr * 64 + fr, col0 = u.pn * 256 + wc * 32 + 4 * fq;
#pragma unroll
        for (int ai = 0; ai < 2; ++ai)
#pragma unroll
            for (int m = 0; m < 4; ++m) { const int row = row0 + ai * 128 + m * 16;
                const float* bp = (row < MP ? base0 + (size_t)row * 1024 : base1 + (size_t)(row - MP) * 1024) + col0;
                const float* gp = gate + (size_t)modrow_of(row) * NMOD + col0; float* op = out + (size_t)row * 1024 + col0;
#pragma unroll
                for (int bj = 0; bj < 2; ++bj)
#pragma unroll
                    for (int n = 0; n < 2; ++n) { const f32x4 b = *(const f32x4*)(bp + bj * 128 + n * 16), gt = *(const f32x4*)(gp + bj * 128 + n * 16);
                        *(f32x4*)(op + bj * 128 + n * 16) = b + gt * acc[ai][bj][m][n]; }
                asm volatile("" ::: "memory"); }
    }
};

struct EpiAct {
    static constexpr bool PERM = true, PAIRED = false;
    bf16_t* O;
    __device__ __forceinline__ void operator()(acc_t& acc, const pg8::Unit& u, int ui, int wr, int wc, int fr, int fq) const {
        const int row0 = u.pm * 256 + wr * 64 + fr, ch0 = u.pn * 128 + wc * 16 + 4 * fq;
#pragma unroll
        for (int ai = 0; ai < 2; ++ai)
#pragma unroll
            for (int m = 0; m < 4; ++m) { bf16_t* rowp = O + (size_t)(row0 + ai * 128 + m * 16) * DFF + ch0;
#pragma unroll
                for (int bj = 0; bj < 2; ++bj) { const f32x4 gt = acc[ai][bj][m][0], up = acc[ai][bj][m][1]; float a[4];
#pragma unroll
                    for (int j = 0; j < 4; ++j) a[j] = gt[j] * up[j] / (1.0f + __expf(-gt[j]));
                    u32x2 w; w.x = cvt_pk_bf16(a[0], a[1]); w.y = cvt_pk_bf16(a[2], a[3]); *(u32x2*)(rowp + bj * 64) = w; } }
    }
};

__device__ __forceinline__ int pairrow(int idx, int n) { const int tp = idx >> 7, w = idx & 127; return 256 * tp + 32 * (w >> 4) + 8 * ((w >> 2) & 3) + 4 * n + (w & 3); }
__device__ __forceinline__ int map_win(int c) {
    if (c < 3072) return c;
    if (c < 3088) return 6144 + (c - 3072);
    if (c < 4112) return 3072 + (c - 3088);
    if (c < 5136) return 4096 + pairrow(c - 4112, 0);
    if (c < 6160) return 4096 + pairrow(c - 5136, 1);
    if (c < 7184) return 6400 + pairrow(c - 6160, 0);
    return 6400 + pairrow(c - 7184, 1);
}
__device__ __forceinline__ void xpose_tile(LAS unsigned char* lds, const float* src, int Nsrc, int k0, int c0, bf16_t* dst, int dpitch, int mapid) {
    const int tid = threadIdx.x;
    LAS bf16_t* T = (LAS bf16_t*)lds;
#pragma unroll
    for (int i = 0; i < 2; ++i) { const int kr = (tid >> 4) + 32 * i, c4 = (tid & 15) * 4, c = c0 + c4;
        f32x4 v = (f32x4){0.f, 0.f, 0.f, 0.f}; if (c < Nsrc) v = *(const f32x4*)(src + (size_t)(k0 + kr) * Nsrc + c);
#pragma unroll
        for (int j = 0; j < 4; ++j) T[(c4 + j) * 72 + kr] = f2bf(v[j]); }
    __syncthreads();
    { const int cc = tid >> 3, part = tid & 7, c = c0 + cc;
      if (c < Nsrc) { int R = c; if (mapid == 1) R = map_win(c); else if (mapid == 2) R = c < DFF ? pairrow(c, 0) : pairrow(c - DFF, 1);
          *(u32x4*)(dst + (size_t)R * dpitch + k0 + part * 8) = *(const LAS u32x4*)(T + cc * 72 + part * 8); } }
    __syncthreads();
}
__device__ void phase0(const Params& P, LAS unsigned char* lds) {
    const int tid = threadIdx.x, G = gridDim.x;
    unsigned char* ws = P.ws;
    { u32x4* z = (u32x4*)(ws + WS_WIN + (size_t)6160 * 2048); const int n16 = 240 * 2048 / 16;
      for (int i = blockIdx.x * 512 + tid; i < n16; i += G * 512) z[i] = (u32x4){0u, 0u, 0u, 0u}; }
    for (int task = blockIdx.x; task < 5136; task += G) {
        if (task < 2064) { const int kt = task / 129, ct = task % 129; xpose_tile(lds, P.in[9], 8208, kt * 64, ct * 64, (bf16_t*)(ws + WS_WIN), 1024, 1); }
        else if (task < 2320) { const int t = task - 2064; xpose_tile(lds, P.in[13], 1024, (t >> 4) * 64, (t & 15) * 64, (bf16_t*)(ws + WS_WGC), 1024, 0); }
        else if (task < 2576) { const int t = task - 2320; xpose_tile(lds, P.in[16], 1024, (t >> 4) * 64, (t & 15) * 64, (bf16_t*)(ws + WS_WGC) + (size_t)1024 * 1024, 1024, 0); }
        else if (task < 2832) { const int t = task - 2576; xpose_tile(lds, P.in[17], 1024, (t >> 4) * 64, (t & 15) * 64, (bf16_t*)(ws + WS_WO), 1024, 0); }
        else if (task < 4240) { const int t = task - 2832; xpose_tile(lds, P.in[19], 5632, (t / 88) * 64, (t % 88) * 64, (bf16_t*)(ws + WS_WF1), 1024, 2); }
        else if (task < 4944) { const int t = task - 4240; xpose_tile(lds, P.in[20], 1024, (t >> 4) * 64, (t & 15) * 64, (bf16_t*)(ws + WS_WF2), DFF, 0); }
        else {
            const int n0 = (task - 4944) * 32;
            LAS float* CL = (LAS float*)lds; LAS float* RED = (LAS float*)(lds + 81920);
            for (int idx = tid; idx < 20480; idx += 512) { const int r = idx >> 10, k = idx & 1023; CL[idx] = r < 4 ? P.in[2][r * 1024 + k] : P.in[3][(r - 4) * 1024 + k]; }
            __syncthreads();
            const int col = tid & 31, ks = tid >> 5; float a[20];
#pragma unroll
            for (int r = 0; r < 20; ++r) a[r] = 0.f;
            const float* wp = P.in[6] + (size_t)(ks * 64) * NMOD + n0 + col;
            for (int kk = 0; kk < 64; ++kk) { const float w = wp[(size_t)kk * NMOD]; const int k = ks * 64 + kk;
#pragma unroll
                for (int r = 0; r < 20; ++r) a[r] += CL[r * 1024 + k] * w; }
#pragma unroll
            for (int r = 0; r < 20; ++r) RED[(ks * 20 + r) * 32 + col] = a[r];
            __syncthreads();
            for (int o = tid; o < 640; o += 512) { const int r = o >> 5, cc = o & 31; float s = P.in[7][n0 + cc];
                for (int q = 0; q < 16; ++q) s += RED[(q * 20 + r) * 32 + cc];
                ((float*)(ws + WS_MOD))[r * NMOD + n0 + cc] = s; }
            __syncthreads();
        }
    }
}

__device__ void phase_norm_mod(const float* x0, const float* x1, const float* gamma, const float* mod, int sh_off, int sc_off, bf16_t* H) {
    const int lane = threadIdx.x & 63, wid = threadIdx.x >> 6;
    for (int row = blockIdx.x * 8 + wid; row < MTOT; row += gridDim.x * 8) {
        const float* xp = row < MP ? x0 + (size_t)row * 1024 : x1 + (size_t)(row - MP) * 1024;
        f32x4 v[4]; float ss = 0.f;
#pragma unroll
        for (int i = 0; i < 2; ++i) { v[2 * i] = *(const f32x4*)(xp + i * 512 + lane * 8); v[2 * i + 1] = *(const f32x4*)(xp + i * 512 + lane * 8 + 4); }
#pragma unroll
        for (int i = 0; i < 4; ++i) ss += v[i][0] * v[i][0] + v[i][1] * v[i][1] + v[i][2] * v[i][2] + v[i][3] * v[i][3];
#pragma unroll
        for (int o = 32; o >= 1; o >>= 1) ss += __shfl_xor(ss, o);
        const float rstd = rsqrtf(ss * (1.0f / 1024.0f) + EPS);
        const float* mp = mod + (size_t)modrow_of(row) * NMOD;
#pragma unroll
        for (int i = 0; i < 2; ++i) { const int c = i * 512 + lane * 8; float o[8];
#pragma unroll
            for (int hlf = 0; hlf < 2; ++hlf) { const f32x4 g = *(const f32x4*)(gamma + c + 4 * hlf), sc = *(const f32x4*)(mp + sc_off + c + 4 * hlf), sh = *(const f32x4*)(mp + sh_off + c + 4 * hlf);
#pragma unroll
                for (int j = 0; j < 4; ++j) o[4 * hlf + j] = v[2 * i + hlf][j] * rstd * g[j] * (1.0f + sc[j]) + sh[j]; }
            u32x4 w; w.x = cvt_pk_bf16(o[0], o[1]); w.y = cvt_pk_bf16(o[2], o[3]); w.z = cvt_pk_bf16(o[4], o[5]); w.w = cvt_pk_bf16(o[6], o[7]);
            *(u32x4*)(H + (size_t)row * 1024 + c) = w; }
    }
}
__device__ void phase_final_norm(float* x, const float* gamma) {
    const int lane = threadIdx.x & 63, wid = threadIdx.x >> 6;
    for (int row = blockIdx.x * 8 + wid; row < MTOT; row += gridDim.x * 8) {
        float* xp = x + (size_t)row * 1024; f32x4 v[4]; float ss = 0.f;
#pragma unroll
        for (int i = 0; i < 4; ++i) v[i] = *(const f32x4*)(xp + i * 256 + lane * 4);
#pragma unroll
        for (int i = 0; i < 4; ++i) ss += v[i][0] * v[i][0] + v[i][1] * v[i][1] + v[i][2] * v[i][2] + v[i][3] * v[i][3];
#pragma unroll
        for (int o = 32; o >= 1; o >>= 1) ss += __shfl_xor(ss, o);
        const float rstd = rsqrtf(ss * (1.0f / 1024.0f) + EPS);
#pragma unroll
        for (int i = 0; i < 4; ++i) { const f32x4 g = *(const f32x4*)(gamma + i * 256 + lane * 4); *(f32x4*)(xp + i * 256 + lane * 4) = v[i] * rstd * g; }
    }
}

__device__ void conv_block(const Params& P, int blk) {
    const int tid = threadIdx.x, cgp = tid & 127, rg = tid >> 7, c0 = cgp * 8;
    const int row0 = blk * 64 + rg * 16;
    const bf16_t* zp = (const bf16_t*)(P.ws + Z_P); bf16_t* zcb = (bf16_t*)(P.ws + Z_CB);
    int seq0, seqlen; float* cache_out;
    if (row0 < MP) { seq0 = row0 & ~4095; seqlen = 4096; cache_out = P.out + O_CP + (size_t)(row0 >> 12) * 2048; }
    else { const int sb = (row0 - MP) >> 5; seq0 = MP + sb * 32; seqlen = 32; cache_out = P.out + O_CS + (size_t)sb * 2048; }
    float w0[8], w1[8], w2[8], bs[8], p1[8], p2[8];
#pragma unroll
    for (int j = 0; j < 8; ++j) { w0[j] = P.in[14][c0 + j]; w1[j] = P.in[14][1024 + c0 + j]; w2[j] = P.in[14][2048 + c0 + j]; bs[j] = P.in[15][c0 + j]; }
    if (row0 == seq0) {
        if (row0 < MP) {
#pragma unroll
            for (int j = 0; j < 8; ++j) { p1[j] = 0.f; p2[j] = 0.f; }
        } else { const float* cp = P.in[5] + (size_t)((row0 - MP) >> 5) * 2048 + c0;
#pragma unroll
            for (int j = 0; j < 8; ++j) { p2[j] = cp[j]; p1[j] = cp[1024 + j]; } }
    } else {
        const u32x4 a = *(const u32x4*)(zp + (size_t)(row0 - 1) * 1024 + c0), b = *(const u32x4*)(zp + (size_t)(row0 - 2) * 1024 + c0);
        p1[0] = bf_lo(a.x); p1[1] = bf_hi(a.x); p1[2] = bf_lo(a.y); p1[3] = bf_hi(a.y); p1[4] = bf_lo(a.z); p1[5] = bf_hi(a.z); p1[6] = bf_lo(a.w); p1[7] = bf_hi(a.w);
        p2[0] = bf_lo(b.x); p2[1] = bf_hi(b.x); p2[2] = bf_lo(b.y); p2[3] = bf_hi(b.y); p2[4] = bf_lo(b.z); p2[5] = bf_hi(b.z); p2[6] = bf_lo(b.w); p2[7] = bf_hi(b.w);
    }
    for (int i = 0; i < 16; ++i) { const int r = row0 + i;
        const u32x4 a = *(const u32x4*)(zp + (size_t)r * 1024 + c0), b = *(const u32x4*)(zcb + (size_t)r * 1024 + c0);
        float p0[8], cb[8], u[8];
        p0[0] = bf_lo(a.x); p0[1] = bf_hi(a.x); p0[2] = bf_lo(a.y); p0[3] = bf_hi(a.y); p0[4] = bf_lo(a.z); p0[5] = bf_hi(a.z); p0[6] = bf_lo(a.w); p0[7] = bf_hi(a.w);
        cb[0] = bf_lo(b.x); cb[1] = bf_hi(b.x); cb[2] = bf_lo(b.y); cb[3] = bf_hi(b.y); cb[4] = bf_lo(b.z); cb[5] = bf_hi(b.z); cb[6] = bf_lo(b.w); cb[7] = bf_hi(b.w);
#pragma unroll
        for (int j = 0; j < 8; ++j) u[j] = cb[j] * (p2[j] * w0[j] + p1[j] * w1[j] + p0[j] * w2[j] + bs[j]);
        u32x4 w; w.x = cvt_pk_bf16(u[0], u[1]); w.y = cvt_pk_bf16(u[2], u[3]); w.z = cvt_pk_bf16(u[4], u[5]); w.w = cvt_pk_bf16(u[6], u[7]);
        *(u32x4*)(zcb + (size_t)r * 1024 + c0) = w;
        const int pos = r - seq0;
        if (pos >= seqlen - 2) { float* co = cache_out + (size_t)(pos - (seqlen - 2)) * 1024 + c0;
            *(f32x4*)co = (f32x4){p0[0], p0[1], p0[2], p0[3]}; *(f32x4*)(co + 4) = (f32x4){p0[4], p0[5], p0[6], p0[7]}; }
#pragma unroll
        for (int j = 0; j < 8; ++j) { p2[j] = p1[j]; p1[j] = p0[j]; }
    }
}

constexpr int L_QE = 0, L_KE = 17408, L_KLT = 34816, L_VT = 53248, L_SC = 90112, L_AL = 99328, L_PSUM = 103424, L_EDEC = 105472, L_PART = 105984, L_LA = 108032, L_GN = 140800;
#define MFMA32(a, b, c) __builtin_amdgcn_mfma_f32_32x32x16_bf16(a, b, c, 0, 0, 0)

template <bool OUT>
__device__ void gla_walk(const Params& P, LAS unsigned char* lds, int h, int tok0, int nchunks, int nvalid, const float* Sinit, float* Sfinal, float* Dout) {
    const int tid = threadIdx.x, lane = tid & 63, w = __builtin_amdgcn_readfirstlane(tid >> 6), r = lane & 31, hh = lane >> 5;
    const int d = tid & 127, tq = tid >> 7;
    const bf16_t* zq = (const bf16_t*)(P.ws + Z_Q); const bf16_t* zk = (const bf16_t*)(P.ws + Z_K); const bf16_t* zv = (const bf16_t*)(P.ws + Z_V);
    bf16_t* zg = (bf16_t*)(P.ws + Z_G); const bf16_t* za = (const bf16_t*)(P.ws + Z_A);
    LAS bf16_t* QE = (LAS bf16_t*)(lds + L_QE); LAS bf16_t* KE = (LAS bf16_t*)(lds + L_KE); LAS bf16_t* KLT = (LAS bf16_t*)(lds + L_KLT);
    LAS bf16_t* VT = (LAS bf16_t*)(lds + L_VT); LAS bf16_t* SC = (LAS bf16_t*)(lds + L_SC);
    LAS float* AL = (LAS float*)(lds + L_AL); LAS float* PSUM = (LAS float*)(lds + L_PSUM); LAS float* EDEC = (LAS float*)(lds + L_EDEC); LAS float* PART = (LAS float*)(lds + L_PART); LAS float* LA = (LAS float*)(lds + L_LA); LAS float* GN = (LAS float*)(lds + L_GN);

    f32x16 S[4];
#pragma unroll
    for (int db = 0; db < 4; ++db)
#pragma unroll
        for (int g = 0; g < 16; ++g) S[db][g] = 0.f;
    if (Sinit) { const float* sp = Sinit + (size_t)(4 * hh) * 256 + 32 * w + r;
#pragma unroll
        for (int db = 0; db < 4; ++db)
#pragma unroll
            for (int q4 = 0; q4 < 4; ++q4) { const float* p = sp + (size_t)(32 * db + 8 * q4) * 256; asm volatile("" : "+v"(p));
                S[db][4 * q4 + 0] = p[0]; S[db][4 * q4 + 1] = p[256]; S[db][4 * q4 + 2] = p[512]; S[db][4 * q4 + 3] = p[768]; } }
    float wal[16];
#pragma unroll
    for (int q = 0; q < 16; ++q) wal[q] = P.in[10][q * 512 + h * 128 + d];
    const float bal = P.in[11][h * 128 + d];
    if (OUT && tid < 256) GN[tid] = P.in[12][tid];
    float dsum = 0.f;

    for (int ck = 0; ck < nchunks; ++ck, tok0 += 64) {
        { const int idx = tid * 2, t = idx >> 4, rr = idx & 15; unsigned two = 0u; if (t < nvalid) two = *(const unsigned*)(za + (size_t)(tok0 + t) * 256 + rr);
          AL[t * 16 + rr] = bf_lo(two); AL[t * 16 + rr + 1] = bf_hi(two); }
        { const int t = tid >> 3;
#pragma unroll
          for (int i = 0; i < 4; ++i) { const int v8 = (tid & 7) * 8 + 64 * i; u32x4 x = (u32x4){0u, 0u, 0u, 0u};
              if (t < nvalid) x = *(const u32x4*)(zv + (size_t)(tok0 + t) * 1024 + h * 256 + v8);
              VT[(v8 + 0) * 72 + t] = (bf16_t)(x.x & 0xffff); VT[(v8 + 1) * 72 + t] = (bf16_t)(x.x >> 16); VT[(v8 + 2) * 72 + t] = (bf16_t)(x.y & 0xffff); VT[(v8 + 3) * 72 + t] = (bf16_t)(x.y >> 16);
              VT[(v8 + 4) * 72 + t] = (bf16_t)(x.z & 0xffff); VT[(v8 + 5) * 72 + t] = (bf16_t)(x.z >> 16); VT[(v8 + 6) * 72 + t] = (bf16_t)(x.w & 0xffff); VT[(v8 + 7) * 72 + t] = (bf16_t)(x.w >> 16); } }
        __syncthreads();
        float run = 0.f;
#pragma unroll 4
        for (int tt = 0; tt < 16; ++tt) { const int t = 16 * tq + tt; float x = bal;
#pragma unroll
            for (int q = 0; q < 16; ++q) x += AL[t * 16 + q] * wal[q];
            float la = (fminf(x, 0.f) - __logf(1.0f + __expf(-fabsf(x)))) * (1.0f / 16.0f);
            if (t >= nvalid) la = 0.f;
            run += la; LA[t * 128 + d] = run; }
        PSUM[tq * 128 + d] = run;
        __syncthreads();
        float off = 0.f, blast = 0.f;
#pragma unroll
        for (int q = 0; q < 4; ++q) { const float ps = PSUM[q * 128 + d]; blast += ps; if (q < tq) off += ps; }
        if (tq == 0) { EDEC[d] = __expf(blast); dsum += blast; }
        { const bf16_t* kp = zk + (size_t)(tok0 + 16 * tq) * 512 + h * 128 + d; const bf16_t* qp = zq + (size_t)(tok0 + 16 * tq) * 512 + h * 128 + d;
#pragma unroll 1
          for (int t4 = 0; t4 < 16; t4 += 4) { float kk[4], qq[4], bb[4];
#pragma unroll
              for (int j = 0; j < 4; ++j) { const int t = 16 * tq + t4 + j; const bool ok = t < nvalid;
                  kk[j] = ok ? bf2f(kp[(size_t)(t4 + j) * 512]) : 0.f; qq[j] = (OUT && ok) ? bf2f(qp[(size_t)(t4 + j) * 512]) : 0.f; bb[j] = off + LA[t * 128 + d]; }
              *(LAS u32x2*)(KLT + d * 72 + 16 * tq + t4) = (u32x2){cvt_pk_bf16(kk[0] * __expf(blast - bb[0]), kk[1] * __expf(blast - bb[1])), cvt_pk_bf16(kk[2] * __expf(blast - bb[2]), kk[3] * __expf(blast - bb[3]))};
              if (OUT) {
#pragma unroll
                  for (int j = 0; j < 4; ++j) { const int t = 16 * tq + t4 + j;
                      QE[t * 136 + d] = f2bf(qq[j] * 0.08838834764831845f * __expf(bb[j])); KE[t * 136 + d] = f2bf(kk[j] * __expf(-bb[j])); } } } }
        __syncthreads();
        if (OUT) {
            if (w < 3) { const int jb = (w == 2) ? 1 : 0, ib = (w == 0) ? 0 : 1;
                f32x16 a = {0.f, 0.f, 0.f, 0.f, 0.f, 0.f, 0.f, 0.f, 0.f, 0.f, 0.f, 0.f, 0.f, 0.f, 0.f, 0.f};
#pragma unroll
                for (int ks = 0; ks < 8; ++ks) { const bf16x8 A = *(const LAS bf16x8*)(KE + (32 * jb + r) * 136 + 16 * ks + 8 * hh), B = *(const LAS bf16x8*)(QE + (32 * ib + r) * 136 + 16 * ks + 8 * hh);
                    a = MFMA32(A, B, a); }
                const int i = 32 * ib + r;
#pragma unroll
                for (int g = 0; g < 4; ++g) { const int j0 = 32 * jb + 8 * g + 4 * hh; float e[4];
#pragma unroll
                    for (int q = 0; q < 4; ++q) e[q] = (j0 + q <= i) ? a[4 * g + q] : 0.f;
                    *(LAS u32x2*)(SC + i * 72 + j0) = (u32x2){cvt_pk_bf16(e[0], e[1]), cvt_pk_bf16(e[2], e[3])}; }
            } else if (w == 3) {
#pragma unroll
                for (int g = 0; g < 4; ++g) *(LAS u32x2*)(SC + r * 72 + 32 + 8 * g + 4 * hh) = (u32x2){0u, 0u};
            }
            __syncthreads();
        }
        bf16x8 vf[4];
#pragma unroll
        for (int ks = 0; ks < 4; ++ks) vf[ks] = *(const LAS bf16x8*)(VT + (32 * w + r) * 72 + 16 * ks + 8 * hh);
        f32x16 oT[2];
        if (OUT) {
#pragma unroll
            for (int ib = 0; ib < 2; ++ib)
#pragma unroll
                for (int g = 0; g < 16; ++g) oT[ib][g] = 0.f;
#pragma unroll
            for (int db = 0; db < 4; ++db)
#pragma unroll
                for (int s = 0; s < 2; ++s) {
                    u32x4 ap; ap.x = cvt_pk_bf16(S[db][8 * s + 0], S[db][8 * s + 1]); ap.y = cvt_pk_bf16(S[db][8 * s + 2], S[db][8 * s + 3]);
                    ap.z = cvt_pk_bf16(S[db][8 * s + 4], S[db][8 * s + 5]); ap.w = cvt_pk_bf16(S[db][8 * s + 6], S[db][8 * s + 7]);
                    const bf16x8 A = __builtin_bit_cast(bf16x8, ap);
#pragma unroll
                    for (int ib = 0; ib < 2; ++ib) { const int i = 32 * ib + r;
                        const u32x2 lo = *(const LAS u32x2*)(QE + i * 136 + 32 * db + 16 * s + 4 * hh), hi = *(const LAS u32x2*)(QE + i * 136 + 32 * db + 16 * s + 8 + 4 * hh);
                        const u32x4 bp = (u32x4){lo.x, lo.y, hi.x, hi.y};
                        oT[ib] = MFMA32(A, __builtin_bit_cast(bf16x8, bp), oT[ib]); }
                    __builtin_amdgcn_sched_barrier(0); }
#pragma unroll
            for (int ks = 0; ks < 4; ++ks)
#pragma unroll
                for (int ib = 0; ib < 2; ++ib) { const bf16x8 B = *(const LAS bf16x8*)(SC + (32 * ib + r) * 72 + 16 * ks + 8 * hh); oT[ib] = MFMA32(vf[ks], B, oT[ib]); }
            __builtin_amdgcn_sched_barrier(0);
        }
#pragma unroll
        for (int db = 0; db < 4; ++db) {
#pragma unroll
            for (int g = 0; g < 4; ++g) { const f32x4 e = *(const LAS f32x4*)(EDEC + 32 * db + 8 * g + 4 * hh);
                S[db][4 * g + 0] *= e[0]; S[db][4 * g + 1] *= e[1]; S[db][4 * g + 2] *= e[2]; S[db][4 * g + 3] *= e[3]; }
#pragma unroll
            for (int ks = 0; ks < 4; ++ks) { const bf16x8 A = *(const LAS bf16x8*)(KLT + (32 * db + r) * 72 + 16 * ks + 8 * hh); S[db] = MFMA32(A, vf[ks], S[db]); }
            __builtin_amdgcn_sched_barrier(0);
        }
        if (OUT) {
#pragma unroll
            for (int ib = 0; ib < 2; ++ib) { float ss = 0.f;
#pragma unroll
                for (int g = 0; g < 16; ++g) ss += oT[ib][g] * oT[ib][g];
                ss += __shfl_xor(ss, 32);
                if (hh == 0) PART[w * 64 + 32 * ib + r] = ss; }
            __syncthreads();
#pragma unroll
            for (int ib = 0; ib < 2; ++ib) { const int t = 32 * ib + r; float tot = 0.f;
#pragma unroll
                for (int q = 0; q < 8; ++q) tot += PART[q * 64 + t];
                const float rstd = rsqrtf(tot * (1.0f / 256.0f) + EPS);
                if (t < nvalid) { bf16_t* gp = zg + (size_t)(tok0 + t) * 1024 + h * 256 + 32 * w + 4 * hh;
#pragma unroll
                    for (int g = 0; g < 4; ++g) { const u32x2 gg = *(const u32x2*)(gp + 8 * g); const f32x4 gn = *(const LAS f32x4*)(GN + 32 * w + 8 * g + 4 * hh);
                        const float g0 = bf_lo(gg.x), g1 = bf_hi(gg.x), g2 = bf_lo(gg.y), g3 = bf_hi(gg.y);
                        const float o0 = oT[ib][4 * g + 0] * rstd * gn[0] * g0 / (1.0f + __expf(-g0));
                        const float o1 = oT[ib][4 * g + 1] * rstd * gn[1] * g1 / (1.0f + __expf(-g1));
                        const float o2 = oT[ib][4 * g + 2] * rstd * gn[2] * g2 / (1.0f + __expf(-g2));
                        const float o3 = oT[ib][4 * g + 3] * rstd * gn[3] * g3 / (1.0f + __expf(-g3));
                        *(u32x2*)(gp + 8 * g) = (u32x2){cvt_pk_bf16(o0, o1), cvt_pk_bf16(o2, o3)}; } } }
        }
        __syncthreads();
    }
    if (Sfinal) { float* sp = Sfinal + (size_t)(4 * hh) * 256 + 32 * w + r;
#pragma unroll
        for (int db = 0; db < 4; ++db)
#pragma unroll
            for (int q4 = 0; q4 < 4; ++q4) { float* p = sp + (size_t)(32 * db + 8 * q4) * 256; asm volatile("" : "+v"(p));
                p[0] = S[db][4 * q4 + 0]; p[256] = S[db][4 * q4 + 1]; p[512] = S[db][4 * q4 + 2]; p[768] = S[db][4 * q4 + 3]; } }
    if (Dout && tq == 0) Dout[d] = __expf(dsum);
}


__device__ __forceinline__ f32x4 small_tile(LAS unsigned char* lds, const bf16_t* A, const bf16_t* Bt, int K, int row0, int col0) {
    const int tid = threadIdx.x, lane = tid & 63, w = __builtin_amdgcn_readfirstlane(tid >> 6), r = lane & 31, hh = lane >> 5;
    const int ksl = K >> 3;
    const bf16_t* ap = A + (size_t)(row0 + r) * K + w * ksl + 8 * hh;
    const bf16_t* b0 = Bt + (size_t)(col0 + r) * K + w * ksl + 8 * hh; const bf16_t* b1 = b0 + (size_t)32 * K;
    f32x16 c0, c1;
#pragma unroll
    for (int g = 0; g < 16; ++g) { c0[g] = 0.f; c1[g] = 0.f; }
    const int nks = ksl >> 4;
#pragma unroll 2
    for (int ks = 0; ks < nks; ++ks) { const bf16x8 a = *(const bf16x8*)(ap + 16 * ks), x = *(const bf16x8*)(b0 + 16 * ks), y = *(const bf16x8*)(b1 + 16 * ks);
        c0 = MFMA32(a, x, c0); c1 = MFMA32(a, y, c1); }
    LAS float* RED = (LAS float*)lds;
#pragma unroll
    for (int g = 0; g < 16; ++g) { const int row = (g & 3) + 8 * (g >> 2) + 4 * hh; RED[(w * 32 + row) * 64 + r] = c0[g]; RED[(w * 32 + row) * 64 + 32 + r] = c1[g]; }
    __syncthreads();
    const int row = tid >> 4, c4 = (tid & 15) * 4; f32x4 sum = (f32x4){0.f, 0.f, 0.f, 0.f};
#pragma unroll
    for (int q = 0; q < 8; ++q) sum += *(const LAS f32x4*)(RED + (q * 32 + row) * 64 + c4);
    __syncthreads();
    return sum;
}

#define XB_TMO      128
#define XB_XCNT(j)  (256  + 64 * (j))
#define XB_XSUB(j)  (1280 + 64 * (j))
#define XB_XGEN(j)  (2304 + 64 * (j))
#define XB_TOP      3328
#define XB_TOPGEN   3392
#define XCD_BAR_WORDS 3456
#define XB_SPIN_CAP (1u << 22)
__device__ __forceinline__ unsigned xb_ld(unsigned* p)              { return __hip_atomic_load(p, __ATOMIC_RELAXED, __HIP_MEMORY_SCOPE_AGENT); }
__device__ __forceinline__ unsigned xb_add(unsigned* p, unsigned v) { return __hip_atomic_fetch_add(p, v, __ATOMIC_RELAXED, __HIP_MEMORY_SCOPE_AGENT); }
__device__ __forceinline__ unsigned xb_xcc_id() { return (unsigned)__builtin_amdgcn_s_getreg((3 << 11) | 20) & 0xFu; }
#define XB_SPIN(cond, bar) do { unsigned _sp = 0; while (cond) { __builtin_amdgcn_s_sleep(1); \
    if ((++_sp & 255u) == 0u) { if (xb_ld(&(bar)[XB_TMO])) break; if (_sp > XB_SPIN_CAP) { atomicAdd(&(bar)[XB_TMO], 1u); break; } } } } while (0)
struct XcdBarrier { unsigned* bar; unsigned x; volatile LAS unsigned* st; };
__device__ __forceinline__ XcdBarrier xcd_barrier_post(unsigned* bar, volatile LAS unsigned* st) {
    XcdBarrier b; b.bar = bar; b.x = xb_xcc_id(); b.st = st;
    if (threadIdx.x == 0) (void)xb_add(&bar[XB_XCNT(b.x)], 1u);
    return b;
}
__device__ __forceinline__ void xcd_barrier_complete(unsigned* bar, unsigned x, unsigned& nloc, unsigned& nx) {
    const unsigned G = gridDim.x * gridDim.y * gridDim.z;
    unsigned sum, cnt, mine, sp = 0u;
    for (;;) {
        sum = 0u; cnt = 0u; mine = 0u;
#pragma unroll
        for (unsigned j = 0; j < 16; ++j) { const unsigned c = xb_ld(&bar[XB_XCNT(j)]); sum += c; cnt += (c > 0u) ? 1u : 0u; mine = (j == x) ? c : mine; }
        if (sum == G) break;
        __builtin_amdgcn_s_sleep(1);
        if ((++sp & 255u) == 0u) { if (xb_ld(&bar[XB_TMO])) break; if (sp > XB_SPIN_CAP) { atomicAdd(&bar[XB_TMO], 1u); break; } }
    }
    nloc = mine > 0u ? mine : 1u; nx = cnt > 0u ? cnt : 1u;
}
__device__ __forceinline__ void xcd_barrier(const XcdBarrier& b) {
    asm volatile("s_waitcnt vmcnt(0)" ::: "memory");
    __syncthreads();
    if (threadIdx.x == 0) {
        unsigned* bar = b.bar;
        __builtin_amdgcn_s_waitcnt(0);
        unsigned nloc = b.st[0], nx = b.st[1];
        if (nloc == 0u) { xcd_barrier_complete(bar, b.x, nloc, nx); b.st[0] = nloc; b.st[1] = nx; }
        const unsigned old = xb_add(&bar[XB_XSUB(b.x)], 1u);
        const unsigned gen = old / nloc;
        if (old + 1u == (gen + 1u) * nloc) {
            __builtin_amdgcn_fence(__ATOMIC_RELEASE, "agent");
            asm volatile("s_waitcnt vmcnt(0)" ::: "memory");
            const unsigned og = xb_add(&bar[XB_TOP], 1u);
            const unsigned tg = og / nx;
            if (og + 1u == (tg + 1u) * nx) xb_add(&bar[XB_TOPGEN], 1u);
            else XB_SPIN(xb_ld(&bar[XB_TOPGEN]) == tg, bar);
            __builtin_amdgcn_fence(__ATOMIC_ACQUIRE, "agent");
            xb_add(&bar[XB_XGEN(b.x)], 1u);
            asm volatile("s_waitcnt vmcnt(0)" ::: "memory");
        } else {
            XB_SPIN(xb_ld(&bar[XB_XGEN(b.x)]) == gen, bar);
            __builtin_amdgcn_fence(__ATOMIC_ACQUIRE, "agent");
            asm volatile("s_waitcnt vmcnt(0)" ::: "memory");
        }
    }
    __syncthreads();
}

__global__ void __launch_bounds__(512, 2) fwd_megakernel(Params P) {
    extern __shared__ __attribute__((aligned(16))) unsigned char lds_raw[];
    LAS unsigned char* lds = (LAS unsigned char*)lds_raw;
    cg::grid_group grid = cg::this_grid();
    const int G = gridDim.x, bid = blockIdx.x, tid = threadIdx.x;
    unsigned char* ws = P.ws;
    float* mod = (float*)(ws + WS_MOD);
    bf16_t* Hb = (bf16_t*)(ws + WS_H);
    bf16_t* Rg = (bf16_t*)P.out;
    bf16_t* Gg = Rg + (size_t)MTOT * 1024;
    volatile LAS unsigned* xst = (volatile LAS unsigned*)(lds + LDS_BYTES - 16);
    if (tid < 4) xst[tid] = 0u;
    __syncthreads();
    const XcdBarrier xbar = xcd_barrier_post((unsigned*)(ws + WS_BAR), xst);
    if (P.ws == nullptr) grid.sync();
#define GRID_SYNC() xcd_barrier(xbar)

#ifndef PHMASK
#define PHMASK 0xffff
#endif
#define PH(n) if ((PHMASK >> (n)) & 1)
    PH(0) phase0(P, lds);
    if (PROBE_P0) { __syncthreads(); phase0(P, lds); }
    for (int q = 0; q < PROBE_SYNC; ++q) GRID_SYNC();
    GRID_SYNC();
    PH(1) phase_norm_mod(P.in[0], P.in[1], P.in[8], mod, 0, 1024, Hb);
    if (PROBE_NORM) phase_norm_mod(P.in[0], P.in[1], P.in[8], mod, 0, 1024, Hb);
    GRID_SYNC();
    PH(2) { pg8::Gemm g{Hb, (const bf16_t*)(ws + WS_WIN), 1024}; pg8::Order S; S.init(66, 33, G, bid);
      EpiIn E{ws, Rg, Gg}; pg8::gemm_phase<EpiIn>(lds, g, S, E); if (PROBE_DUP) pg8::gemm_phase<EpiIn>(lds, g, S, E); }
    GRID_SYNC();
    if (PROBE_GLA1) for (int it = bid; it < 240; it += G) { const int bh = it / 15, seg = it % 15, b = bh >> 2, h = bh & 3;
            gla_walk<false>(P, lds, h, b * 4096 + seg * (SEGCH * 64), SEGCH, 64, nullptr, (float*)(ws + SEG_STATE) + (size_t)(bh * 16 + seg) * 32768, (float*)(ws + SEG_DEC) + (size_t)(bh * 16 + seg) * 128); }
    PH(3) for (int it = bid; it < 304; it += G) {
        if (it < 240) { const int bh = it / 15, seg = it % 15, b = bh >> 2, h = bh & 3;
            gla_walk<false>(P, lds, h, b * 4096 + seg * (SEGCH * 64), SEGCH, 64, nullptr, (float*)(ws + SEG_STATE) + (size_t)(bh * 16 + seg) * 32768, (float*)(ws + SEG_DEC) + (size_t)(bh * 16 + seg) * 128);
        } else { const int sbh = it - 240, sb = sbh >> 2, h = sbh & 3;
            gla_walk<true>(P, lds, h, MP + sb * 32, 1, 32, P.in[4] + (size_t)sbh * 32768, P.out + O_SS + (size_t)sbh * 32768, nullptr); }
    }
    PH(4) for (int blk = bid; blk < 264; blk += G) conv_block(P, blk);
    GRID_SYNC();
    for (int e4 = bid * 512 + tid; e4 < 16 * 8192; e4 += G * 512) { const int bh = e4 >> 13, idx = (e4 & 8191) * 4, dd = idx >> 8;
        f32x4 s = (f32x4){0.f, 0.f, 0.f, 0.f};
        for (int seg = 0; seg < 15; ++seg) { float* lp = (float*)(ws + SEG_STATE) + (size_t)(bh * 16 + seg) * 32768 + idx;
            const float dc = ((const float*)(ws + SEG_DEC))[(bh * 16 + seg) * 128 + dd];
            s = s * dc + *(const f32x4*)lp; *(f32x4*)lp = s; } }
    GRID_SYNC();
    PH(5) for (int it = bid; it < 256; it += G) { const int bh = it >> 4, seg = it & 15, b = bh >> 2, h = bh & 3;
        gla_walk<true>(P, lds, h, b * 4096 + seg * (SEGCH * 64), SEGCH, 64, seg ? (const float*)(ws + SEG_STATE) + (size_t)(bh * 16 + seg - 1) * 32768 : nullptr,
                       seg == 15 ? P.out + O_SP + (size_t)bh * 32768 : nullptr, nullptr); }
    GRID_SYNC();
    PH(6) { pg8::Gemm g{(const bf16_t*)(ws + Z_G), (const bf16_t*)(ws + WS_WGC), 1024}; pg8::Order S; S.init(64, 4, G, bid, 1, 66, 4);
      EpiMerge E{Rg, Gg, (bf16_t*)(ws + Z_V)}; pg8::gemm_phase<EpiMerge>(lds, g, S, E); if (PROBE_DUP) pg8::gemm_phase<EpiMerge>(lds, g, S, E);
      for (int tl = bid; tl < 256; tl += G) { const int row0 = MP + (tl >> 4) * 32, col0 = (tl & 15) * 64;
          const f32x4 ya = small_tile(lds, (const bf16_t*)(ws + Z_G), (const bf16_t*)(ws + WS_WGC), 1024, row0, col0);
          const f32x4 yb = small_tile(lds, (const bf16_t*)(ws + Z_CB), (const bf16_t*)(ws + WS_WGC) + (size_t)1024 * 1024, 1024, row0, col0);
          const size_t o = (size_t)(row0 + (tid >> 4)) * 1024 + col0 + (tid & 15) * 4;
          const u32x2 rr = *(const u32x2*)(Rg + o), gg = *(const u32x2*)(Gg + o);
          const float m0 = bf_lo(gg.x) * (bf_lo(rr.x) * ya[0] + yb[0]), m1 = bf_hi(gg.x) * (bf_hi(rr.x) * ya[1] + yb[1]);
          const float m2 = bf_lo(gg.y) * (bf_lo(rr.y) * ya[2] + yb[2]), m3 = bf_hi(gg.y) * (bf_hi(rr.y) * ya[3] + yb[3]);
          *(u32x2*)((bf16_t*)(ws + Z_V) + o) = (u32x2){cvt_pk_bf16(m0, m1), cvt_pk_bf16(m2, m3)}; } }
    GRID_SYNC();
    PH(7) { pg8::Gemm g{(const bf16_t*)(ws + Z_V), (const bf16_t*)(ws + WS_WO), 1024}; pg8::Order S; S.init(64, 4, G, bid);
      EpiRes E{P.in[0], P.in[1], P.out, mod + 2048}; pg8::gemm_phase<EpiRes>(lds, g, S, E); if (PROBE_DUP) pg8::gemm_phase<EpiRes>(lds, g, S, E);
      for (int tl = bid; tl < 256; tl += G) { const int row0 = MP + (tl >> 4) * 32, col0 = (tl & 15) * 64;
          const f32x4 a = small_tile(lds, (const bf16_t*)(ws + Z_V), (const bf16_t*)(ws + WS_WO), 1024, row0, col0);
          const int row = row0 + (tid >> 4), col = col0 + (tid & 15) * 4;
          const f32x4 xb = *(const f32x4*)(P.in[1] + (size_t)(row - MP) * 1024 + col), gt = *(const f32x4*)(mod + 2048 + (size_t)modrow_of(row) * NMOD + col);
          *(f32x4*)(P.out + (size_t)row * 1024 + col) = xb + gt * a; } }
    GRID_SYNC();
    PH(8) phase_norm_mod(P.out, P.out + (size_t)MP * 1024, P.in[18], mod, 3072, 4096, Hb);
    GRID_SYNC();
    PH(9) { pg8::Gemm g{Hb, (const bf16_t*)(ws + WS_WF1), 1024}; pg8::Order S; S.init(66, 22, G, bid);
      EpiAct E{(bf16_t*)(ws + WS_Z)}; pg8::gemm_phase<EpiAct>(lds, g, S, E); if (PROBE_DUP) pg8::gemm_phase<EpiAct>(lds, g, S, E); }
    GRID_SYNC();
    PH(10) { pg8::Gemm g{(const bf16_t*)(ws + WS_Z), (const bf16_t*)(ws + WS_WF2), DFF}; pg8::Order S; S.init(64, 4, G, bid);
      EpiRes E{P.out, P.out + (size_t)MP * 1024, P.out, mod + 5120}; pg8::gemm_phase<EpiRes>(lds, g, S, E);
      for (int tl = bid; tl < 256; tl += G) { const int row0 = MP + (tl >> 4) * 32, col0 = (tl & 15) * 64;
          const f32x4 a = small_tile(lds, (const bf16_t*)(ws + WS_Z), (const bf16_t*)(ws + WS_WF2), DFF, row0, col0);
          const int row = row0 + (tid >> 4), col = col0 + (tid & 15) * 4;
          float* op = P.out + (size_t)row * 1024 + col;
          const f32x4 xb = *(const f32x4*)op, gt = *(const f32x4*)(mod + 5120 + (size_t)modrow_of(row) * NMOD + col);
          *(f32x4*)op = xb + gt * a; } }
    GRID_SYNC();
    PH(11) phase_final_norm(P.out, P.in[21]);
}

extern "C" void kernel_launch(void* const* d_in, const int* in_sizes, int n_in, void* d_out, int out_size, void* d_ws, size_t ws_size, hipStream_t stream) {
    static int grid_blocks = 0;
    if (grid_blocks == 0) {
        if (n_in != 22 || ws_size < WS_END) { fprintf(stderr, "kernel_launch: unexpected n_in %d / ws %zu (need %zu)\n", n_in, ws_size, (size_t)WS_END); grid_blocks = -1; return; }
        int dev = 0, cus = 0, per_cu = 0;
        hipGetDevice(&dev); hipDeviceGetAttribute(&cus, hipDeviceAttributeMultiprocessorCount, dev);
        if (hipFuncSetAttribute((const void*)fwd_megakernel, hipFuncAttributeMaxDynamicSharedMemorySize, LDS_BYTES) != hipSuccess) { fprintf(stderr, "kernel_launch: hipFuncSetAttribute failed\n"); grid_blocks = -1; return; }
        hipOccupancyMaxActiveBlocksPerMultiprocessor(&per_cu, (const void*)fwd_megakernel, 512, LDS_BYTES);
        (void)hipGetLastError();
        if (per_cu < 1) per_cu = 1;
        grid_blocks = cus;
        fprintf(stderr, "kernel_launch: cus %d per_cu %d grid %d\n", cus, per_cu, grid_blocks);
    }
    if (grid_blocks < 0) return;
    if (hipMemsetAsync((char*)d_ws + WS_BAR, 0, 16384, stream) != hipSuccess) { fprintf(stderr, "kernel_launch: memset failed\n"); return; }
    Params p{};
    for (int i = 0; i < 22; ++i) p.in[i] = (const float*)d_in[i];
    p.out = (float*)d_out; p.ws = (unsigned char*)d_ws;
    void* args[] = {&p};
    hipError_t e = hipLaunchCooperativeKernel((const void*)fwd_megakernel, dim3(grid_blocks), dim3(512), args, LDS_BYTES, stream);
    if (e != hipSuccess) fprintf(stderr, "cooperative launch failed: %s (grid %d)\n", hipGetErrorString(e), grid_blocks);
}
```

```cpp
#include <hip/hip_runtime.h>
#include <hip/hip_cooperative_groups.h>
#include <cstdio>
#include <cstdint>
namespace cg = cooperative_groups;

#define LAS __attribute__((address_space(3)))
typedef unsigned short bf16_t;
typedef short bf16x8 __attribute__((ext_vector_type(8)));
typedef float f32x4 __attribute__((ext_vector_type(4)));
typedef float f32x16 __attribute__((ext_vector_type(16)));
typedef unsigned u32x4 __attribute__((ext_vector_type(4)));
typedef unsigned u32x2 __attribute__((ext_vector_type(2)));

constexpr int DM = 1024, MP = 16384, MTOT = 16896, NMODROW = 20, NMOD = 6144;
constexpr int NIN = 8448;
constexpr int DFF = 2816;
constexpr int NSEG = 16, SEGCH = 4;
constexpr float EPS = 1e-6f;

constexpr size_t WS_WIN = 0;
constexpr size_t WS_WGC = WS_WIN + (size_t)NIN * 1024 * 2;
constexpr size_t WS_WO  = WS_WGC + (size_t)2 * 1024 * 1024 * 2;
constexpr size_t WS_WF1 = WS_WO + (size_t)1024 * 1024 * 2;
constexpr size_t WS_WF2 = WS_WF1 + (size_t)5632 * 1024 * 2;
constexpr size_t WS_MOD = WS_WF2 + (size_t)1024 * 2816 * 2;
constexpr size_t WS_H   = WS_MOD + (size_t)NMODROW * NMOD * 4;
constexpr size_t WS_Z   = WS_H + (size_t)MTOT * 1024 * 2;
constexpr size_t Z_Q = WS_Z;
constexpr size_t Z_K = Z_Q + (size_t)MTOT * 512 * 2;
constexpr size_t Z_V = Z_K + (size_t)MTOT * 512 * 2;
constexpr size_t Z_G = Z_V + (size_t)MTOT * 1024 * 2;
constexpr size_t Z_CB = Z_G + (size_t)MTOT * 1024 * 2;
constexpr size_t Z_P = Z_CB + (size_t)MTOT * 1024 * 2;
constexpr size_t Z_A = Z_P + (size_t)MTOT * 1024 * 2;
constexpr size_t WS_BAR = Z_A + (size_t)MTOT * 256 * 2;
constexpr size_t WS_CNT = WS_BAR + 16384;
constexpr size_t WS_RSS = WS_CNT + 65536;
constexpr size_t WS_RSS2 = WS_RSS + 65536;
constexpr size_t WS_END = WS_RSS2 + 65536;
constexpr size_t SEG_STATE = WS_H;
constexpr size_t SEG_DEC = WS_H + (size_t)16 * 16 * 32768 * 4;
static_assert(SEG_DEC + 16 * 16 * 128 * 4 <= WS_Z, "seg state fits in H");
static_assert(WS_END <= (size_t)256 * 1024 * 1024, "ws");
constexpr size_t O_Y = 0, O_SP = 17301504, O_CP = 17825792, O_SS = 17833984, O_CS = 19931136;

constexpr int LDS_BYTES = 144 * 1024;
#ifndef WGM_BIG
#define WGM_BIG 4
#endif
#ifndef PROBE_DUP
#define PROBE_DUP 0
#endif
#ifndef PROBE_P0
#define PROBE_P0 0
#endif
#ifndef PROBE_NORM
#define PROBE_NORM 0
#endif
#ifndef PROBE_GLA1
#define PROBE_GLA1 0
#endif
#ifndef PROBE_SYNC
#define PROBE_SYNC 0
#endif

struct Params { const float* in[22]; float* out; unsigned char* ws; };

__device__ __forceinline__ unsigned cvt_pk_bf16(float lo, float hi) { unsigned r; asm("v_cvt_pk_bf16_f32 %0, %1, %2" : "=v"(r) : "v"(lo), "v"(hi)); return r; }
__device__ __forceinline__ float bf_lo(unsigned w) { return __uint_as_float(w << 16); }
__device__ __forceinline__ float bf_hi(unsigned w) { return __uint_as_float(w & 0xffff0000u); }
__device__ __forceinline__ float bf2f(bf16_t b) { return __uint_as_float(((unsigned)b) << 16); }
__device__ __forceinline__ bf16_t f2bf(float f) { return (bf16_t)(cvt_pk_bf16(f, 0.f) & 0xffffu); }
__device__ __forceinline__ float sigmoidf_(float x) { return 1.0f / (1.0f + __expf(-x)); }
__device__ __forceinline__ int opaque_tid() { int t = threadIdx.x; asm volatile("" : "+v"(t)); return t; }
__device__ __forceinline__ int modrow_of(int row) { return row < MP ? (row >> 12) : 4 + ((row - MP) >> 5); }

namespace pg8 {
constexpr int BM = 256, BK = 64, HALF = 128, HTB = HALF * BK * 2, STAGE_BYTES = 8 * HTB, NXCD = 8, WGM = 8;
__host__ __device__ __forceinline__ int lds_byte(int r, int c) { const int st = (r >> 4) * 2 + (c >> 5), rr = r & 15, cc = c & 31, ob = rr * 64 + cc * 2; return st * 1024 + (ob ^ (((ob >> 9) & 1) << 5)); }
__host__ __device__ __forceinline__ void stage_rc(int b, int& R, int& C) { const int st = b / 1024, sb = b % 1024, swz = sb ^ (((sb >> 9) & 1) << 5); R = (st >> 1) * 16 + swz / 64; C = (st & 1) * 32 + (swz % 64) / 2; }
__host__ __device__ __forceinline__ int perm32(int rho) { const int n = rho >> 4, i = rho & 15; return 8 * (i >> 2) + 4 * n + (i & 3); }

struct Unit { int pm, pn; };
struct Gemm { const bf16_t* A; const bf16_t* Bt; int K; };

struct Order {
    int nM, nN, nwg, G, c, paired, dpm, dpn, wgm;
    __device__ void init(int nM_, int nN_, int G_, int c_, int paired_ = 0, int dpm_ = 0, int dpn_ = 0, int wgm_ = WGM) { nM = nM_; nN = nN_; nwg = nM * nN; G = G_; c = c_; paired = paired_; dpm = dpm_; dpn = dpn_; wgm = wgm_; }
    __device__ bool next(int i, Unit& u) const {
        const int it = paired ? (i >> 1) : i;
        const long L = (long)it * G + c; if (L >= nwg) return false;
        int wgid = (int)L; { const int q = nwg / NXCD, r = nwg % NXCD, xcd = wgid % NXCD, off = wgid / NXCD; wgid = (xcd < r ? xcd * (q + 1) : r * (q + 1) + (xcd - r) * q) + off; }
        const int nig = wgm * nN, gid = wgid / nig, fm = gid * wgm, gsz = (nM - fm) < wgm ? (nM - fm) : wgm;
        u.pm = fm + ((wgid % nig) % gsz); u.pn = (wgid % nig) / gsz;
        if (paired && (i & 1)) { u.pm += dpm; u.pn += dpn; }
        return true;
    }
};

template <class Epi>
__device__ __forceinline__ void gemm_phase(LAS unsigned char* lds, const Gemm g, const Order& S, const Epi& E) {
    const int tid = opaque_tid(), wid = __builtin_amdgcn_readfirstlane(tid >> 6), lane = tid & 63, wr = wid >> 2, wc = wid & 3, fr = lane & 15, fq = lane >> 4;
    const int K = g.K, nt = K / BK;
    unsigned voffA[2], voffB[2];
#pragma unroll
    for (int i = 0; i < 2; ++i) { int R, C; stage_rc(tid * 16 + i * 8192, R, C); const int Rb = Epi::PERM ? ((R & ~31) + perm32(R & 31)) : R;
        voffA[i] = (unsigned)(R * K + C) * 2u; voffB[i] = (unsigned)(Rb * K + C) * 2u; }
    const size_t kstep = (size_t)(BK * 2);
    const size_t hstep = (size_t)HALF * K * 2;
    const size_t tstep = 2 * hstep;
    const unsigned ldsw = (unsigned)wid * 1024u;
    const int aoff = lds_byte(wr * 64 + fr, fq * 8), boff = lds_byte(wc * 32 + fr, fq * 8);
#define PG8_SA(b, h) (((b) * 2 + (h)) * HTB)
#define PG8_SB(b, h) ((4 + (b) * 2 + (h)) * HTB)
#define PG8_STAGE(bufoff, gbase, voff) do { _Pragma("unroll") for (int _i = 0; _i < 2; ++_i) \
        __builtin_amdgcn_global_load_lds((const unsigned*)((const char*)(gbase) + (voff)[_i]), (LAS unsigned*)(lds + (bufoff) + ldsw + _i * 8192), 16, 0, 0); } while (0)
#define PG8_LDA(dst, b, h) do { _Pragma("unroll") for (int m = 0; m < 4; ++m) _Pragma("unroll") for (int k = 0; k < 2; ++k) dst[m][k] = *(const LAS bf16x8*)(lds + PG8_SA(b, h) + aoff + m * 2048 + k * 1024); } while (0)
#define PG8_LDB(dst, b, h) do { _Pragma("unroll") for (int n = 0; n < 2; ++n) _Pragma("unroll") for (int k = 0; k < 2; ++k) dst[n][k] = *(const LAS bf16x8*)(lds + PG8_SB(b, h) + boff + n * 2048 + k * 1024); } while (0)
#define PG8_MMA(ai, bj, At, Bt) do { __builtin_amdgcn_s_setprio(1); _Pragma("unroll") for (int m = 0; m < 4; ++m) _Pragma("unroll") for (int n = 0; n < 2; ++n) _Pragma("unroll") for (int k = 0; k < 2; ++k) \
        acc[ai][bj][m][n] = __builtin_amdgcn_mfma_f32_16x16x32_bf16(Bt[n][k], At[m][k], acc[ai][bj][m][n], 0, 0, 0); __builtin_amdgcn_s_setprio(0); } while (0)
#define PG8_WAIT_V(n) asm volatile("s_waitcnt vmcnt(" #n ")" ::: "memory")
#define PG8_WAIT_L(n) asm volatile("s_waitcnt lgkmcnt(" #n ")" ::: "memory")
#define PG8_BAR __builtin_amdgcn_s_barrier()
#define PG8_SCHED __builtin_amdgcn_sched_barrier(0)
    Unit cur, nxt; int ui = 0;
    if (!S.next(0, cur)) return;
    f32x4 acc[2][2][4][2];
#pragma unroll
    for (int a = 0; a < 2; ++a)
#pragma unroll
        for (int b = 0; b < 2; ++b)
#pragma unroll
            for (int m = 0; m < 4; ++m)
#pragma unroll
                for (int n = 0; n < 2; ++n) acc[a][b][m][n] = (f32x4){0.f, 0.f, 0.f, 0.f};
    bf16x8 At[4][2], B0[2][2], B1[2][2];
    const char* cA = (const char*)g.A + (size_t)cur.pm * tstep; const char* cB = (const char*)g.Bt + (size_t)cur.pn * tstep;
    PG8_STAGE(PG8_SB(0, 0), cB, voffB); PG8_STAGE(PG8_SB(0, 1), cB + hstep, voffB); PG8_STAGE(PG8_SA(0, 0), cA, voffA); PG8_STAGE(PG8_SA(0, 1), cA + hstep, voffA);
    if (wr == 1) PG8_BAR;
    PG8_WAIT_V(2); PG8_BAR;
    PG8_STAGE(PG8_SB(1, 0), cB + kstep, voffB); PG8_STAGE(PG8_SA(1, 0), cA + kstep, voffA); PG8_STAGE(PG8_SB(1, 1), cB + hstep + kstep, voffB);
    PG8_WAIT_V(6); PG8_BAR;
    for (;;) {
        const bool has_next = S.next(ui + 1, nxt);
        const char* nA = has_next ? (const char*)g.A + (size_t)nxt.pm * tstep : cA; const char* nB = has_next ? (const char*)g.Bt + (size_t)nxt.pn * tstep : cB;
        for (int t = 0; t < nt; t += 2) {
            const bool last = (t == nt - 2);
            const char* a1 = cA + (size_t)(t + 1) * kstep;
            const char* a2 = last ? nA : cA + (size_t)(t + 2) * kstep; const char* b2 = last ? nB : cB + (size_t)(t + 2) * kstep;
            const char* a3 = a2 + kstep; const char* b3 = b2 + kstep;
            PG8_LDB(B0, 0, 0); PG8_LDB(B1, 0, 1); PG8_SCHED; PG8_LDA(At, 0, 0); PG8_STAGE(PG8_SA(1, 1), a1 + hstep, voffA);
            PG8_WAIT_V(8); PG8_WAIT_L(0); PG8_BAR; PG8_MMA(0, 0, At, B0); PG8_MMA(0, 1, At, B1); PG8_BAR; PG8_SCHED;
            PG8_LDA(At, 0, 1); PG8_STAGE(PG8_SB(0, 0), b2, voffB); PG8_STAGE(PG8_SB(0, 1), b2 + hstep, voffB); PG8_STAGE(PG8_SA(0, 0), a2, voffA);
            PG8_WAIT_V(8); PG8_WAIT_L(0); PG8_BAR; PG8_MMA(1, 0, At, B0); PG8_MMA(1, 1, At, B1); PG8_BAR; PG8_SCHED;
            PG8_LDB(B0, 1, 0); PG8_LDB(B1, 1, 1); PG8_SCHED; PG8_LDA(At, 1, 0); PG8_STAGE(PG8_SA(0, 1), a2 + hstep, voffA);
            PG8_WAIT_V(8); PG8_WAIT_L(0); PG8_BAR; PG8_MMA(0, 0, At, B0); PG8_MMA(0, 1, At, B1); PG8_BAR; PG8_SCHED;
            PG8_LDA(At, 1, 1); PG8_STAGE(PG8_SB(1, 0), b3, voffB); PG8_STAGE(PG8_SB(1, 1), b3 + hstep, voffB); PG8_STAGE(PG8_SA(1, 0), a3, voffA);
            PG8_WAIT_V(8); PG8_WAIT_L(0); PG8_BAR; PG8_MMA(1, 0, At, B0); PG8_MMA(1, 1, At, B1); PG8_BAR; PG8_SCHED;
        }
        if (wr == 0) PG8_BAR;
        E(acc, cur, ui, wr, wc, fr, fq);
        if (!has_next) break;
        if (!(Epi::PAIRED && (ui & 1) == 0)) {
#pragma unroll
            for (int a = 0; a < 2; ++a)
#pragma unroll
                for (int b = 0; b < 2; ++b)
#pragma unroll
                    for (int m = 0; m < 4; ++m)
#pragma unroll
                        for (int n = 0; n < 2; ++n) acc[a][b][m][n] = (f32x4){0.f, 0.f, 0.f, 0.f};
        }
        cur = nxt; cA = nA; cB = nB; ++ui;
        if (wr == 1) PG8_BAR;
    }
    PG8_WAIT_V(0);
    PG8_BAR;
#undef PG8_SA
#undef PG8_SB
#undef PG8_STAGE
#undef PG8_LDA
#undef PG8_LDB
#undef PG8_MMA
#undef PG8_WAIT_V
#undef PG8_WAIT_L
#undef PG8_BAR
#undef PG8_SCHED
}
}

typedef f32x4 acc_t[2][2][4][2];

struct EpiIn {
    static constexpr bool PERM = true, PAIRED = false;
    unsigned char* ws; bf16_t* Rg; bf16_t* Gg;
    __device__ __forceinline__ void operator()(acc_t& acc, const pg8::Unit& u, int ui, int wr, int wc, int fr, int fq) const {
        const int row0 = u.pm * 256 + wr * 64 + fr; const int pn = u.pn;
        if (pn < 16 || pn == 24) {
            bf16_t* base; int ldc, colt;
            if (pn < 2) { base = (bf16_t*)(ws + Z_Q); ldc = 512; colt = pn * 256; }
            else if (pn < 4) { base = (bf16_t*)(ws + Z_K); ldc = 512; colt = (pn - 2) * 256; }
            else if (pn < 8) { base = (bf16_t*)(ws + Z_V); ldc = 1024; colt = (pn - 4) * 256; }
            else if (pn < 12) { base = (bf16_t*)(ws + Z_G); ldc = 1024; colt = (pn - 8) * 256; }
            else if (pn < 16) { base = (bf16_t*)(ws + Z_CB); ldc = 1024; colt = (pn - 12) * 256; }
            else { base = (bf16_t*)(ws + Z_A); ldc = 256; colt = 0; }
            const int col0 = colt + wc * 32 + 8 * fq;
#pragma unroll
            for (int ai = 0; ai < 2; ++ai)
#pragma unroll
                for (int m = 0; m < 4; ++m) { bf16_t* rowp = base + (size_t)(row0 + ai * 128 + m * 16) * ldc + col0;
#pragma unroll
                    for (int bj = 0; bj < 2; ++bj) { const f32x4 v0 = acc[ai][bj][m][0], v1 = acc[ai][bj][m][1];
                        u32x4 w; w.x = cvt_pk_bf16(v0[0], v0[1]); w.y = cvt_pk_bf16(v0[2], v0[3]); w.z = cvt_pk_bf16(v1[0], v1[1]); w.w = cvt_pk_bf16(v1[2], v1[3]);
                        *(u32x4*)(rowp + bj * 128) = w; } }
        } else if (pn < 24) {
            bf16_t* base = (bf16_t*)(ws + Z_P); const int ch0 = (pn - 16) * 128 + wc * 16 + 4 * fq;
#pragma unroll
            for (int ai = 0; ai < 2; ++ai)
#pragma unroll
                for (int m = 0; m < 4; ++m) { bf16_t* rowp = base + (size_t)(row0 + ai * 128 + m * 16) * 1024 + ch0;
#pragma unroll
                    for (int bj = 0; bj < 2; ++bj) { const f32x4 p = acc[ai][bj][m][0] * acc[ai][bj][m][1];
                        u32x2 w; w.x = cvt_pk_bf16(p[0], p[1]); w.y = cvt_pk_bf16(p[2], p[3]); *(u32x2*)(rowp + bj * 64) = w; } }
        } else {
            const int ch0 = (pn - 25) * 128 + wc * 16 + 4 * fq;
#pragma unroll
            for (int ai = 0; ai < 2; ++ai)
#pragma unroll
                for (int m = 0; m < 4; ++m) { const size_t ro = (size_t)(row0 + ai * 128 + m * 16) * 1024 + ch0;
#pragma unroll
                    for (int bj = 0; bj < 2; ++bj) { const f32x4 ga = acc[ai][bj][m][0], gb = acc[ai][bj][m][1]; float r[4], s[4];
#pragma unroll
                        for (int j = 0; j < 4; ++j) { const float ea = __expf(-ga[j]), eb = __expf(-gb[j]); s[j] = __builtin_amdgcn_rcpf(1.0f + eb); r[j] = (1.0f + eb) * __builtin_amdgcn_rcpf(1.0f + ea); }
                        u32x2 w; w.x = cvt_pk_bf16(r[0], r[1]); w.y = cvt_pk_bf16(r[2], r[3]); *(u32x2*)(Rg + ro + bj * 64) = w;
                        u32x2 x; x.x = cvt_pk_bf16(s[0], s[1]); x.y = cvt_pk_bf16(s[2], s[3]); *(u32x2*)(Gg + ro + bj * 64) = x; } }
        }
    }
};

struct EpiMerge {
    static constexpr bool PERM = true, PAIRED = true;
    const bf16_t* Rg; const bf16_t* Gg; bf16_t* O;
    __device__ __forceinline__ void operator()(acc_t& acc, const pg8::Unit& u, int ui, int wr, int wc, int fr, int fq) const {
        const int second = ui & 1; const int pm = second ? u.pm - 66 : u.pm, pn = second ? u.pn - 4 : u.pn;
        const int row0 = pm * 256 + wr * 64 + fr, col0 = pn * 256 + wc * 32 + 8 * fq;
        const bf16_t* src = second ? Gg : Rg;
#pragma unroll
        for (int ai = 0; ai < 2; ++ai) { u32x4 ff[4][2];
#pragma unroll
            for (int m = 0; m < 4; ++m)
#pragma unroll
                for (int bj = 0; bj < 2; ++bj) ff[m][bj] = *(const u32x4*)(src + (size_t)(row0 + ai * 128 + m * 16) * 1024 + col0 + bj * 128);
#pragma unroll
            for (int m = 0; m < 4; ++m) { const size_t ro = (size_t)(row0 + ai * 128 + m * 16) * 1024 + col0;
#pragma unroll
                for (int bj = 0; bj < 2; ++bj) { const u32x4 f = ff[m][bj];
                    f32x4 v0 = acc[ai][bj][m][0], v1 = acc[ai][bj][m][1];
                    v0[0] *= bf_lo(f.x); v0[1] *= bf_hi(f.x); v0[2] *= bf_lo(f.y); v0[3] *= bf_hi(f.y);
                    v1[0] *= bf_lo(f.z); v1[1] *= bf_hi(f.z); v1[2] *= bf_lo(f.w); v1[3] *= bf_hi(f.w);
                    if (second) { u32x4 w; w.x = cvt_pk_bf16(v0[0], v0[1]); w.y = cvt_pk_bf16(v0[2], v0[3]); w.z = cvt_pk_bf16(v1[0], v1[1]); w.w = cvt_pk_bf16(v1[2], v1[3]);
                        *(u32x4*)(O + ro + bj * 128) = w; }
                    else { acc[ai][bj][m][0] = v0; acc[ai][bj][m][1] = v1; } } } }
    }
};

struct EpiRes {
    static constexpr bool PERM = false, PAIRED = false;
    const float* base0; const float* base1;
    float* out; const float* gate;
    __device__ __forceinline__ void operator()(acc_t& acc, const pg8::Unit& u, int ui, int wr, int wc, int fr, int fq) const {
        const int row0 = u.pm * 256 + wr * 64 + fr, col0 = u.pn * 256 + wc * 32 + 4 * fq;
#pragma unroll
        for (int ai = 0; ai < 2; ++ai)
#pragma unroll
            for (int m = 0; m < 4; ++m) { const int row = row0 + ai * 128 + m * 16;
                const float* bp = (row < MP ? base0 + (size_t)row * 1024 : base1 + (size_t)(row - MP) * 1024) + col0;
                const float* gp = gate + (size_t)modrow_of(row) * NMOD + col0; float* op = out + (size_t)row * 1024 + col0;
#pragma unroll
                for (int bj = 0; bj < 2; ++bj)
#pragma unroll
                    for (int n = 0; n < 2; ++n) { const f32x4 b = *(const f32x4*)(bp + bj * 128 + n * 16), gt = *(const f32x4*)(gp + bj * 128 + n * 16);
                        *(f32x4*)(op + bj * 128 + n * 16) = b + gt * acc[ai][bj][m][n]; }
                asm volatile("" ::: "memory"); }
    }
};

struct EpiResNorm {
    static constexpr bool PERM = false, PAIRED = false;
    const float* base; float* out; const float* gate; const float* gamma; float* rowss; unsigned* cnt;
    __device__ __forceinline__ void operator()(acc_t& acc, const pg8::Unit& u, int ui, int wr, int wc, int fr, int fq) const {
        const int row0 = u.pm * 256 + wr * 64 + fr, col0 = u.pn * 256 + wc * 32 + 4 * fq;
        const float* gp = gate + (size_t)modrow_of(u.pm * 256) * NMOD + col0;
        f32x4 gt[2][2];
#pragma unroll
        for (int bj = 0; bj < 2; ++bj)
#pragma unroll
            for (int n = 0; n < 2; ++n) gt[bj][n] = *(const f32x4*)(gp + bj * 128 + n * 16);
#pragma unroll
        for (int ai = 0; ai < 2; ++ai)
#pragma unroll
            for (int m = 0; m < 4; ++m) { const int row = row0 + ai * 128 + m * 16; const float* bp = base + (size_t)row * 1024 + col0; float ss = 0.f;
#pragma unroll
                for (int bj = 0; bj < 2; ++bj)
#pragma unroll
                    for (int n = 0; n < 2; ++n) { const f32x4 b = *(const f32x4*)(bp + bj * 128 + n * 16); const f32x4 o = b + gt[bj][n] * acc[ai][bj][m][n]; acc[ai][bj][m][n] = o;
                        ss += o[0] * o[0] + o[1] * o[1] + o[2] * o[2] + o[3] * o[3]; }
                ss += __shfl_xor(ss, 16); ss += __shfl_xor(ss, 32);
                if (fq == 0) (void)__hip_atomic_fetch_add(rowss + row, ss, __ATOMIC_RELAXED, __HIP_MEMORY_SCOPE_AGENT);
                asm volatile("" ::: "memory"); }
        asm volatile("s_waitcnt vmcnt(0)" ::: "memory");
        __syncthreads();
        if (threadIdx.x == 0) { (void)__hip_atomic_fetch_add(cnt + 64 * u.pm, 1u, __ATOMIC_RELAXED, __HIP_MEMORY_SCOPE_AGENT);
            unsigned sp = 0u; while (__hip_atomic_load(cnt + 64 * u.pm, __ATOMIC_RELAXED, __HIP_MEMORY_SCOPE_AGENT) < 4u) { __builtin_amdgcn_s_sleep(2); if (++sp > (1u << 22)) break; } }
        __syncthreads();
        float rs[8];
#pragma unroll
        for (int gi = 0; gi < 8; ++gi) rs[gi] = __hip_atomic_load(rowss + row0 + (gi >> 2) * 128 + (gi & 3) * 16, __ATOMIC_RELAXED, __HIP_MEMORY_SCOPE_AGENT);
        f32x4 gm[2][2];
#pragma unroll
        for (int bj = 0; bj < 2; ++bj)
#pragma unroll
            for (int n = 0; n < 2; ++n) gm[bj][n] = *(const f32x4*)(gamma + col0 + bj * 128 + n * 16);
#pragma unroll
        for (int ai = 0; ai < 2; ++ai)
#pragma unroll
            for (int m = 0; m < 4; ++m) { const float r_ = rsqrtf(rs[ai * 4 + m] * (1.0f / 1024.0f) + EPS); float* op = out + (size_t)(row0 + ai * 128 + m * 16) * 1024 + col0;
#pragma unroll
                for (int bj = 0; bj < 2; ++bj)
#pragma unroll
                    for (int n = 0; n < 2; ++n) *(f32x4*)(op + bj * 128 + n * 16) = acc[ai][bj][m][n] * r_ * gm[bj][n]; }
    }
};

struct EpiResNormMod {
    static constexpr bool PERM = false, PAIRED = false;
    const float* base; float* out; bf16_t* H; const float* mod; const float* g2n; float* rowss; unsigned* cnt;
    __device__ __forceinline__ void operator()(acc_t& acc, const pg8::Unit& u, int ui, int wr, int wc, int fr, int fq) const {
        const int row0 = u.pm * 256 + wr * 64 + fr, col0 = u.pn * 256 + wc * 32 + 4 * fq;
        const float* mp = mod + (size_t)modrow_of(u.pm * 256) * NMOD + col0;
        { f32x4 gt[2][2];
#pragma unroll
          for (int bj = 0; bj < 2; ++bj)
#pragma unroll
              for (int n = 0; n < 2; ++n) gt[bj][n] = *(const f32x4*)(mp + 2048 + bj * 128 + n * 16);
#pragma unroll
          for (int ai = 0; ai < 2; ++ai)
#pragma unroll
              for (int m = 0; m < 4; ++m) { const int row = row0 + ai * 128 + m * 16; const size_t oo = (size_t)row * 1024 + col0; float ss = 0.f;
#pragma unroll
                  for (int bj = 0; bj < 2; ++bj)
#pragma unroll
                      for (int n = 0; n < 2; ++n) { const f32x4 b = *(const f32x4*)(base + oo + bj * 128 + n * 16); const f32x4 o = b + gt[bj][n] * acc[ai][bj][m][n]; acc[ai][bj][m][n] = o;
                          *(f32x4*)(out + oo + bj * 128 + n * 16) = o; ss += o[0] * o[0] + o[1] * o[1] + o[2] * o[2] + o[3] * o[3]; }
                  ss += __shfl_xor(ss, 16); ss += __shfl_xor(ss, 32);
                  if (fq == 0) (void)__hip_atomic_fetch_add(rowss + row, ss, __ATOMIC_RELAXED, __HIP_MEMORY_SCOPE_AGENT);
                  asm volatile("" ::: "memory"); } }
        asm volatile("s_waitcnt vmcnt(0)" ::: "memory");
        __syncthreads();
        if (threadIdx.x == 0) { (void)__hip_atomic_fetch_add(cnt + 64 * u.pm, 1u, __ATOMIC_RELAXED, __HIP_MEMORY_SCOPE_AGENT);
            unsigned sp = 0u; while (__hip_atomic_load(cnt + 64 * u.pm, __ATOMIC_RELAXED, __HIP_MEMORY_SCOPE_AGENT) < 4u) { __builtin_amdgcn_s_sleep(2); if (++sp > (1u << 22)) break; } }
        __syncthreads();
        float rs[8];
#pragma unroll
        for (int gi = 0; gi < 8; ++gi) rs[gi] = __hip_atomic_load(rowss + row0 + (gi >> 2) * 128 + (gi & 3) * 16, __ATOMIC_RELAXED, __HIP_MEMORY_SCOPE_AGENT);
        f32x4 fs[2][2], sh[2][2];
#pragma unroll
        for (int bj = 0; bj < 2; ++bj)
#pragma unroll
            for (int n = 0; n < 2; ++n) { const f32x4 sc = *(const f32x4*)(mp + 4096 + bj * 128 + n * 16), gm = *(const f32x4*)(g2n + col0 + bj * 128 + n * 16);
                fs[bj][n] = gm * (sc + 1.0f); sh[bj][n] = *(const f32x4*)(mp + 3072 + bj * 128 + n * 16); }
#pragma unroll
        for (int ai = 0; ai < 2; ++ai)
#pragma unroll
            for (int m = 0; m < 4; ++m) { const float r_ = rsqrtf(rs[ai * 4 + m] * (1.0f / 1024.0f) + EPS); bf16_t* hp = H + (size_t)(row0 + ai * 128 + m * 16) * 1024 + col0;
#pragma unroll
                for (int bj = 0; bj < 2; ++bj)
#pragma unroll
                    for (int n = 0; n < 2; ++n) { const f32x4 h = acc[ai][bj][m][n] * r_ * fs[bj][n] + sh[bj][n];
                        *(u32x2*)(hp + bj * 128 + n * 16) = (u32x2){cvt_pk_bf16(h[0], h[1]), cvt_pk_bf16(h[2], h[3])}; } }
    }
};

struct EpiAct {
    static constexpr bool PERM = true, PAIRED = false;
    bf16_t* O;
    __device__ __forceinline__ void operator()(acc_t& acc, const pg8::Unit& u, int ui, int wr, int wc, int fr, int fq) const {
        const int row0 = u.pm * 256 + wr * 64 + fr, ch0 = u.pn * 128 + wc * 16 + 4 * fq;
#pragma unroll
        for (int ai = 0; ai < 2; ++ai)
#pragma unroll
            for (int m = 0; m < 4; ++m) { bf16_t* rowp = O + (size_t)(row0 + ai * 128 + m * 16) * DFF + ch0;
#pragma unroll
                for (int bj = 0; bj < 2; ++bj) { const f32x4 gt = acc[ai][bj][m][0], up = acc[ai][bj][m][1]; float a[4];
#pragma unroll
                    for (int j = 0; j < 4; ++j) a[j] = gt[j] * up[j] * __builtin_amdgcn_rcpf(1.0f + __expf(-gt[j]));
                    u32x2 w; w.x = cvt_pk_bf16(a[0], a[1]); w.y = cvt_pk_bf16(a[2], a[3]); *(u32x2*)(rowp + bj * 64) = w; } }
    }
};

__device__ __forceinline__ int pairrow(int idx, int n) { const int tp = idx >> 7, w = idx & 127; return 256 * tp + 32 * (w >> 4) + 8 * ((w >> 2) & 3) + 4 * n + (w & 3); }
__device__ __forceinline__ int map_win(int c) {
    if (c < 3072) return c;
    if (c < 3088) return 6144 + (c - 3072);
    if (c < 4112) return 3072 + (c - 3088);
    if (c < 5136) return 4096 + pairrow(c - 4112, 0);
    if (c < 6160) return 4096 + pairrow(c - 5136, 1);
    if (c < 7184) return 6400 + pairrow(c - 6160, 0);
    return 6400 + pairrow(c - 7184, 1);
}
__device__ __forceinline__ void xpose_wave4(const float* src, int Nsrc, int k0, int c0, bf16_t* dst, int dpitch, int mapid, int lane) {
    const int c = c0 + 4 * lane; if (c >= Nsrc) return;
    const float* sp = src + (size_t)k0 * Nsrc + c;
    f32x4 v[32];
#pragma unroll
    for (int j = 0; j < 32; ++j) v[j] = *(const f32x4*)(sp + (size_t)j * Nsrc);
#pragma unroll
    for (int q = 0; q < 4; ++q) { const int cc = c + q; int R = cc; if (mapid == 1) R = map_win(cc); else if (mapid == 2) R = cc < DFF ? pairrow(cc, 0) : pairrow(cc - DFF, 1);
        bf16_t* dp = dst + (size_t)R * dpitch + k0;
#pragma unroll
        for (int kg = 0; kg < 4; ++kg) { u32x4 w; w.x = cvt_pk_bf16(v[kg * 8 + 0][q], v[kg * 8 + 1][q]); w.y = cvt_pk_bf16(v[kg * 8 + 2][q], v[kg * 8 + 3][q]);
            w.z = cvt_pk_bf16(v[kg * 8 + 4][q], v[kg * 8 + 5][q]); w.w = cvt_pk_bf16(v[kg * 8 + 6][q], v[kg * 8 + 7][q]); *(u32x4*)(dp + kg * 8) = w; } }
}
__device__ __forceinline__ void xpose_task(const Params& P, int task, int lane) {
    unsigned char* ws = P.ws;
    if (task < 1056) { xpose_wave4(P.in[9], 8208, (task / 33) * 32, (task % 33) * 256, (bf16_t*)(ws + WS_WIN), 1024, 1, lane); }
    else if (task < 1184) { const int t = task - 1056; xpose_wave4(P.in[13], 1024, (t >> 2) * 32, (t & 3) * 256, (bf16_t*)(ws + WS_WGC), 1024, 0, lane); }
    else if (task < 1312) { const int t = task - 1184; xpose_wave4(P.in[16], 1024, (t >> 2) * 32, (t & 3) * 256, (bf16_t*)(ws + WS_WGC) + (size_t)1024 * 1024, 1024, 0, lane); }
    else if (task < 1440) { const int t = task - 1312; xpose_wave4(P.in[17], 1024, (t >> 2) * 32, (t & 3) * 256, (bf16_t*)(ws + WS_WO), 1024, 0, lane); }
    else if (task < 2144) { const int t = task - 1440; xpose_wave4(P.in[19], 5632, (t / 22) * 32, (t % 22) * 256, (bf16_t*)(ws + WS_WF1), 1024, 2, lane); }
    else { const int t = task - 2144; xpose_wave4(P.in[20], 1024, (t >> 2) * 32, (t & 3) * 256, (bf16_t*)(ws + WS_WF2), DFF, 0, lane); }
}
__device__ void phase0(const Params& P, LAS unsigned char* lds) {
    const int tid = opaque_tid(), G = gridDim.x;
    unsigned char* ws = P.ws;
    { u32x4* z = (u32x4*)(ws + WS_WIN + (size_t)6160 * 2048); const int n16 = 240 * 2048 / 16;
      for (int i = blockIdx.x * 512 + tid; i < n16; i += G * 512) z[i] = (u32x4){0u, 0u, 0u, 0u}; }
    { const int lane = tid & 63, wid = tid >> 6;
      for (int task = blockIdx.x * 8 + wid; task < 2496; task += G * 8) xpose_task(P, task, lane); }
    for (int task2 = (int)G - 1 - (int)blockIdx.x; task2 < 192; task2 += G) {
        const int task = task2 >> 1, kh = task2 & 1;
        const int lane = tid & 63, wid = __builtin_amdgcn_readfirstlane(tid >> 6), n0 = task * 64;
        LAS float* CL = (LAS float*)lds; LAS float* RED = (LAS float*)(lds + 81920);
#pragma unroll
        for (int i = 0; i < 2; ++i) { const int idx = (tid + i * 512) * 4; *(LAS f32x4*)(CL + idx) = *(const f32x4*)(P.in[2] + idx); }
#pragma unroll
        for (int i = 0; i < 8; ++i) { const int idx = (tid + i * 512) * 4; *(LAS f32x4*)(CL + 4096 + idx) = *(const f32x4*)(P.in[3] + idx); }
        __syncthreads();
        float a[20];
#pragma unroll
        for (int r = 0; r < 20; ++r) a[r] = 0.f;
        const int kb = kh * 512 + wid * 64;
        const float* wp = P.in[6] + (size_t)kb * NMOD + n0 + lane;
#pragma unroll 4
        for (int k8 = 0; k8 < 64; k8 += 8) { float wv[8];
#pragma unroll
            for (int j = 0; j < 8; ++j) wv[j] = wp[(size_t)(k8 + j) * NMOD];
#pragma unroll
            for (int r = 0; r < 20; ++r) { const f32x4 c0 = *(const LAS f32x4*)(CL + r * 1024 + kb + k8), c1 = *(const LAS f32x4*)(CL + r * 1024 + kb + k8 + 4);
                a[r] += c0[0] * wv[0] + c0[1] * wv[1] + c0[2] * wv[2] + c0[3] * wv[3] + c1[0] * wv[4] + c1[1] * wv[5] + c1[2] * wv[6] + c1[3] * wv[7]; } }
#pragma unroll
        for (int r = 0; r < 20; ++r) RED[(wid * 20 + r) * 64 + lane] = a[r];
        __syncthreads();
        for (int o = tid; o < 1280; o += 512) { const int r = o >> 6, cc = o & 63; float sum = kh ? 0.f : P.in[7][n0 + cc];
#pragma unroll
            for (int q = 0; q < 8; ++q) sum += RED[(q * 20 + r) * 64 + cc];
            atomicAdd((float*)(ws + WS_MOD) + r * NMOD + n0 + cc, sum); }
        __syncthreads();
    }
}

__device__ void phase_norm_mod(const float* x0, const float* x1, const float* gamma, const float* mod, int sh_off, int sc_off, bf16_t* H) {
    const int tid_ = opaque_tid(), lane = tid_ & 63, wid = tid_ >> 6; const int stride = gridDim.x * 8;
    for (int rowa = blockIdx.x * 8 + wid; rowa < MTOT; rowa += 2 * stride) {
        const int rowb = rowa + stride; const bool hasb = rowb < MTOT; const int rb = hasb ? rowb : rowa;
        const float* xa = rowa < MP ? x0 + (size_t)rowa * 1024 : x1 + (size_t)(rowa - MP) * 1024;
        const float* xb = rb < MP ? x0 + (size_t)rb * 1024 : x1 + (size_t)(rb - MP) * 1024;
        f32x4 v[2][4];
#pragma unroll
        for (int i = 0; i < 2; ++i) { v[0][2 * i] = *(const f32x4*)(xa + i * 512 + lane * 8); v[0][2 * i + 1] = *(const f32x4*)(xa + i * 512 + lane * 8 + 4);
                                      v[1][2 * i] = *(const f32x4*)(xb + i * 512 + lane * 8); v[1][2 * i + 1] = *(const f32x4*)(xb + i * 512 + lane * 8 + 4); }
#pragma unroll
        for (int q = 0; q < 2; ++q) { const int row = q ? rb : rowa; if (q && !hasb) break;
            float ss = 0.f;
#pragma unroll
            for (int i = 0; i < 4; ++i) ss += v[q][i][0] * v[q][i][0] + v[q][i][1] * v[q][i][1] + v[q][i][2] * v[q][i][2] + v[q][i][3] * v[q][i][3];
#pragma unroll
            for (int o = 32; o >= 1; o >>= 1) ss += __shfl_xor(ss, o);
            const float rstd = rsqrtf(ss * (1.0f / 1024.0f) + EPS);
            const float* mp = mod + (size_t)modrow_of(row) * NMOD;
#pragma unroll
            for (int i = 0; i < 2; ++i) { const int c = i * 512 + lane * 8; float o[8];
#pragma unroll
                for (int hlf = 0; hlf < 2; ++hlf) { const f32x4 g = *(const f32x4*)(gamma + c + 4 * hlf), sc = *(const f32x4*)(mp + sc_off + c + 4 * hlf), sh = *(const f32x4*)(mp + sh_off + c + 4 * hlf);
#pragma unroll
                    for (int j = 0; j < 4; ++j) o[4 * hlf + j] = v[q][2 * i + hlf][j] * rstd * g[j] * (1.0f + sc[j]) + sh[j]; }
                u32x4 w; w.x = cvt_pk_bf16(o[0], o[1]); w.y = cvt_pk_bf16(o[2], o[3]); w.z = cvt_pk_bf16(o[4], o[5]); w.w = cvt_pk_bf16(o[6], o[7]);
                *(u32x4*)(H + (size_t)row * 1024 + c) = w; } }
    }
}
__device__ void phase_final_norm(float* x, const float* gamma) {
    const int tid_ = opaque_tid(), lane = tid_ & 63, wid = tid_ >> 6; const int stride = gridDim.x * 8;
    f32x4 g[4];
#pragma unroll
    for (int i = 0; i < 4; ++i) g[i] = *(const f32x4*)(gamma + i * 256 + lane * 4);
    for (int rowa = blockIdx.x * 8 + wid; rowa < MTOT; rowa += 2 * stride) {
        const int rowb = rowa + stride; const bool hasb = rowb < MTOT;
        float* xa = x + (size_t)rowa * 1024; float* xb = x + (size_t)(hasb ? rowb : rowa) * 1024; f32x4 v[2][4];
#pragma unroll
        for (int i = 0; i < 4; ++i) { v[0][i] = *(const f32x4*)(xa + i * 256 + lane * 4); v[1][i] = *(const f32x4*)(xb + i * 256 + lane * 4); }
#pragma unroll
        for (int q = 0; q < 2; ++q) { if (q && !hasb) break; float* xp = q ? xb : xa; float ss = 0.f;
#pragma unroll
            for (int i = 0; i < 4; ++i) ss += v[q][i][0] * v[q][i][0] + v[q][i][1] * v[q][i][1] + v[q][i][2] * v[q][i][2] + v[q][i][3] * v[q][i][3];
#pragma unroll
            for (int o = 32; o >= 1; o >>= 1) ss += __shfl_xor(ss, o);
            const float rstd = rsqrtf(ss * (1.0f / 1024.0f) + EPS);
#pragma unroll
            for (int i = 0; i < 4; ++i) *(f32x4*)(xp + i * 256 + lane * 4) = v[q][i] * rstd * g[i]; }
    }
}

__device__ void conv_block(const Params& P, int blk) {
    const int tid = opaque_tid(), cgp = tid & 127, rg = tid >> 7, c0 = cgp * 8;
    const int row0 = blk * 64 + rg * 16;
    const bf16_t* zp = (const bf16_t*)(P.ws + Z_P); bf16_t* zcb = (bf16_t*)(P.ws + Z_CB);
    int seq0, seqlen; float* cache_out;
    if (row0 < MP) { seq0 = row0 & ~4095; seqlen = 4096; cache_out = P.out + O_CP + (size_t)(row0 >> 12) * 2048; }
    else { const int sb = (row0 - MP) >> 5; seq0 = MP + sb * 32; seqlen = 32; cache_out = P.out + O_CS + (size_t)sb * 2048; }
    float w0[8], w1[8], w2[8], bs[8], p1[8], p2[8];
#pragma unroll
    for (int j = 0; j < 8; ++j) { w0[j] = P.in[14][c0 + j]; w1[j] = P.in[14][1024 + c0 + j]; w2[j] = P.in[14][2048 + c0 + j]; bs[j] = P.in[15][c0 + j]; }
    if (row0 == seq0) {
        if (row0 < MP) {
#pragma unroll
            for (int j = 0; j < 8; ++j) { p1[j] = 0.f; p2[j] = 0.f; }
        } else { const float* cp = P.in[5] + (size_t)((row0 - MP) >> 5) * 2048 + c0;
#pragma unroll
            for (int j = 0; j < 8; ++j) { p2[j] = cp[j]; p1[j] = cp[1024 + j]; } }
    } else {
        const u32x4 a = *(const u32x4*)(zp + (size_t)(row0 - 1) * 1024 + c0), b = *(const u32x4*)(zp + (size_t)(row0 - 2) * 1024 + c0);
        p1[0] = bf_lo(a.x); p1[1] = bf_hi(a.x); p1[2] = bf_lo(a.y); p1[3] = bf_hi(a.y); p1[4] = bf_lo(a.z); p1[5] = bf_hi(a.z); p1[6] = bf_lo(a.w); p1[7] = bf_hi(a.w);
        p2[0] = bf_lo(b.x); p2[1] = bf_hi(b.x); p2[2] = bf_lo(b.y); p2[3] = bf_hi(b.y); p2[4] = bf_lo(b.z); p2[5] = bf_hi(b.z); p2[6] = bf_lo(b.w); p2[7] = bf_hi(b.w);
    }
#pragma unroll 1
    for (int i0 = 0; i0 < 16; i0 += 8) {
        u32x4 av[8], bv[8];
#pragma unroll
        for (int i = 0; i < 8; ++i) { av[i] = *(const u32x4*)(zp + (size_t)(row0 + i0 + i) * 1024 + c0); bv[i] = *(const u32x4*)(zcb + (size_t)(row0 + i0 + i) * 1024 + c0); }
#pragma unroll
        for (int i = 0; i < 8; ++i) { const int r = row0 + i0 + i; const u32x4 a = av[i], b = bv[i];
            float p0[8], cb[8], u[8];
            p0[0] = bf_lo(a.x); p0[1] = bf_hi(a.x); p0[2] = bf_lo(a.y); p0[3] = bf_hi(a.y); p0[4] = bf_lo(a.z); p0[5] = bf_hi(a.z); p0[6] = bf_lo(a.w); p0[7] = bf_hi(a.w);
            cb[0] = bf_lo(b.x); cb[1] = bf_hi(b.x); cb[2] = bf_lo(b.y); cb[3] = bf_hi(b.y); cb[4] = bf_lo(b.z); cb[5] = bf_hi(b.z); cb[6] = bf_lo(b.w); cb[7] = bf_hi(b.w);
#pragma unroll
            for (int j = 0; j < 8; ++j) u[j] = cb[j] * (p2[j] * w0[j] + p1[j] * w1[j] + p0[j] * w2[j] + bs[j]);
            u32x4 w; w.x = cvt_pk_bf16(u[0], u[1]); w.y = cvt_pk_bf16(u[2], u[3]); w.z = cvt_pk_bf16(u[4], u[5]); w.w = cvt_pk_bf16(u[6], u[7]);
            *(u32x4*)(zcb + (size_t)r * 1024 + c0) = w;
            const int pos = r - seq0;
            if (pos >= seqlen - 2) { float* co = cache_out + (size_t)(pos - (seqlen - 2)) * 1024 + c0;
                *(f32x4*)co = (f32x4){p0[0], p0[1], p0[2], p0[3]}; *(f32x4*)(co + 4) = (f32x4){p0[4], p0[5], p0[6], p0[7]}; }
#pragma unroll
            for (int j = 0; j < 8; ++j) { p2[j] = p1[j]; p1[j] = p0[j]; }
        }
    }
}

constexpr int L_QE = 0, L_KE = 17408, L_KLT = 34816, L_VT = 53248, L_SC = 90112, L_AL = 99328, L_PSUM = 103424, L_EDEC = 105472, L_PART = 105984, L_LA = 108032, L_GN = 140800;
#define MFMA32(a, b, c) __builtin_amdgcn_mfma_f32_32x32x16_bf16(a, b, c, 0, 0, 0)

#define LBAR() do { asm volatile("s_waitcnt lgkmcnt(0)" ::: "memory"); __builtin_amdgcn_s_barrier(); asm volatile("" ::: "memory"); } while (0)
template <bool OUT>
__device__ void gla_walk(const Params& P, LAS unsigned char* lds, int h, int tok0, int nchunks, int nvalid, const float* Sinit, float* Sfinal, float* Dout) {
    const int tid = opaque_tid(), lane = tid & 63, w = __builtin_amdgcn_readfirstlane(tid >> 6), r = lane & 31, hh = lane >> 5;
    const int d = tid & 127, tq = tid >> 7;
    const bf16_t* zq = (const bf16_t*)(P.ws + Z_Q); const bf16_t* zk = (const bf16_t*)(P.ws + Z_K); const bf16_t* zv = (const bf16_t*)(P.ws + Z_V);
    bf16_t* zg = (bf16_t*)(P.ws + Z_G); const bf16_t* za = (const bf16_t*)(P.ws + Z_A);
    LAS bf16_t* QE = (LAS bf16_t*)(lds + L_QE); LAS bf16_t* KE = (LAS bf16_t*)(lds + L_KE); LAS bf16_t* KLT = (LAS bf16_t*)(lds + L_KLT);
    LAS bf16_t* VT = (LAS bf16_t*)(lds + L_VT); LAS bf16_t* SC = (LAS bf16_t*)(lds + L_SC);
    LAS float* AL = (LAS float*)(lds + L_AL); LAS float* PSUM = (LAS float*)(lds + L_PSUM); LAS float* EDEC = (LAS float*)(lds + L_EDEC); LAS float* PART = (LAS float*)(lds + L_PART); LAS float* LA = (LAS float*)(lds + L_LA); LAS float* GN = (LAS float*)(lds + L_GN);

    f32x16 S[4];
#pragma unroll
    for (int db = 0; db < 4; ++db)
#pragma unroll
        for (int g = 0; g < 16; ++g) S[db][g] = 0.f;
    if (Sinit) { const float* sp = Sinit + (size_t)(4 * hh) * 256 + 32 * w + r;
#pragma unroll
        for (int db = 0; db < 4; ++db)
#pragma unroll
            for (int q4 = 0; q4 < 4; ++q4) { const float* p = sp + (size_t)(32 * db + 8 * q4) * 256; asm volatile("" : "+v"(p));
                S[db][4 * q4 + 0] = p[0]; S[db][4 * q4 + 1] = p[256]; S[db][4 * q4 + 2] = p[512]; S[db][4 * q4 + 3] = p[768]; } }
    const int tb = w >> 2, dbx = w & 3; const bool okb = 32 * tb < nvalid;
    bf16x8 wB; { u32x4 t_; const float* wp_ = P.in[10] + (size_t)(8 * hh) * 512 + h * 128 + 32 * dbx + r;
        t_.x = cvt_pk_bf16(wp_[0], wp_[512]); t_.y = cvt_pk_bf16(wp_[1024], wp_[1536]); t_.z = cvt_pk_bf16(wp_[2048], wp_[2560]); t_.w = cvt_pk_bf16(wp_[3072], wp_[3584]); wB = __builtin_bit_cast(bf16x8, t_); }
    const float balx = P.in[11][h * 128 + 32 * dbx + r];
    if (OUT && tid < 256) GN[tid] = P.in[12][tid];
    float dsum = 0.f;

#ifndef PROBE_G
#define PROBE_G 0
#endif
    volatile LAS unsigned* gts = (volatile LAS unsigned*)(lds + LDS_BYTES - 128 + 56);
    u32x4 av; unsigned vv[16]; unsigned short kr[16], qr[16]; const bool okq = 16 * tq < nvalid;
#define GLA_LOAD(TB) do { \
        av = *(const u32x4*)(za + (size_t)((TB) + (okb ? 32 * tb + r : 0)) * 256 + 8 * hh); \
        { const bf16_t* vb = zv + (size_t)(TB) * 1024 + h * 256; \
          const unsigned vo = (16u * (okq ? (unsigned)tq : 0u)) * 1024u + 2u * (unsigned)d; \
          _Pragma("unroll") \
          for (int tt = 0; tt < 16; ++tt) { const bf16_t* vbt = vb + tt * 1024; const unsigned vraw = *(const unsigned*)(vbt + vo); vv[tt] = okq ? vraw : 0u; } } } while (0)
#define GLA_LOADK(TB) do { \
        { const bf16_t* kb = zk + (size_t)(TB) * 512 + h * 128; \
          const unsigned ko = (16u * (okq ? (unsigned)tq : 0u)) * 512u + (unsigned)d; \
          _Pragma("unroll") \
          for (int tt = 0; tt < 16; ++tt) { const bf16_t* kbt = kb + tt * 512; const unsigned short kraw = kbt[ko]; kr[tt] = okq ? kraw : (unsigned short)0; } } } while (0)
    GLA_LOAD(tok0);
#pragma unroll 1
    for (int ck = 0; ck < nchunks; ++ck, tok0 += 64) {
        unsigned g_t0 = 0; if (PROBE_G && OUT && nvalid == 64 && blockIdx.x == 0 && tid == 0) g_t0 = (unsigned)__builtin_amdgcn_s_memrealtime();
        GLA_LOADK(tok0);
        { u32x4 e0, e1, o0, o1;
          e0.x = (vv[0] & 0xffffu) | (vv[1] << 16); e0.y = (vv[2] & 0xffffu) | (vv[3] << 16); e0.z = (vv[4] & 0xffffu) | (vv[5] << 16); e0.w = (vv[6] & 0xffffu) | (vv[7] << 16);
          e1.x = (vv[8] & 0xffffu) | (vv[9] << 16); e1.y = (vv[10] & 0xffffu) | (vv[11] << 16); e1.z = (vv[12] & 0xffffu) | (vv[13] << 16); e1.w = (vv[14] & 0xffffu) | (vv[15] << 16);
          o0.x = (vv[0] >> 16) | (vv[1] & 0xffff0000u); o0.y = (vv[2] >> 16) | (vv[3] & 0xffff0000u); o0.z = (vv[4] >> 16) | (vv[5] & 0xffff0000u); o0.w = (vv[6] >> 16) | (vv[7] & 0xffff0000u);
          o1.x = (vv[8] >> 16) | (vv[9] & 0xffff0000u); o1.y = (vv[10] >> 16) | (vv[11] & 0xffff0000u); o1.z = (vv[12] >> 16) | (vv[13] & 0xffff0000u); o1.w = (vv[14] >> 16) | (vv[15] & 0xffff0000u);
          *(LAS u32x4*)(VT + (2 * d) * 72 + 16 * tq) = e0; *(LAS u32x4*)(VT + (2 * d) * 72 + 16 * tq + 8) = e1;
          *(LAS u32x4*)(VT + (2 * d + 1) * 72 + 16 * tq) = o0; *(LAS u32x4*)(VT + (2 * d + 1) * 72 + 16 * tq + 8) = o1; }
        if (OUT) { const bf16_t* qb = zq + (size_t)tok0 * 512 + h * 128; const unsigned qo = (16u * (okq ? (unsigned)tq : 0u)) * 512u + (unsigned)d;
#pragma unroll
            for (int tt = 0; tt < 16; ++tt) { const bf16_t* qbt = qb + tt * 512; const unsigned short qraw = qbt[qo]; qr[tt] = okq ? qraw : (unsigned short)0; } }
        { f32x16 xa;
#pragma unroll
          for (int g = 0; g < 16; ++g) xa[g] = balx;
          xa = MFMA32(__builtin_bit_cast(bf16x8, av), wB, xa);
          float T[4], To[4];
#pragma unroll
          for (int q4 = 0; q4 < 4; ++q4) { float run = 0.f;
#pragma unroll
              for (int e = 0; e < 4; ++e) { const float x = xa[4 * q4 + e];
                  float la = (fminf(x, 0.f) - __logf(1.0f + __expf(-fabsf(x)))) * (1.0f / 16.0f);
                  if (!okb) la = 0.f;
                  run += la; xa[4 * q4 + e] = run; }
              T[q4] = run; }
#pragma unroll
          for (int q4 = 0; q4 < 4; ++q4) To[q4] = __shfl_xor(T[q4], 32);
          float base = 0.f;
#pragma unroll
          for (int q4 = 0; q4 < 4; ++q4) { const float mine = base + (hh ? To[q4] : 0.f);
#pragma unroll
              for (int e = 0; e < 4; ++e) LA[(32 * tb + 8 * q4 + 4 * hh + e) * 128 + 32 * dbx + r] = xa[4 * q4 + e] + mine;
              base += T[q4] + To[q4]; }
          if (hh == 0) PSUM[tb * 128 + 32 * dbx + r] = base; }
        LBAR();
        const float ps0 = PSUM[d], ps1 = PSUM[128 + d];
        const float off = (tq >> 1) ? ps0 : 0.f, blast = ps0 + ps1;
        if (tq == 0) { EDEC[d] = __expf(blast); dsum += blast; }
#pragma unroll
        for (int t4 = 0; t4 < 16; t4 += 4) { float kk[4], bb[4];
#pragma unroll
            for (int j = 0; j < 4; ++j) { kk[j] = bf2f(kr[t4 + j]); bb[j] = off + LA[(16 * tq + t4 + j) * 128 + d]; }
            *(LAS u32x2*)(KLT + d * 72 + 16 * tq + t4) = (u32x2){cvt_pk_bf16(kk[0] * __expf(blast - bb[0]), kk[1] * __expf(blast - bb[1])), cvt_pk_bf16(kk[2] * __expf(blast - bb[2]), kk[3] * __expf(blast - bb[3]))};
            if (OUT) {
#pragma unroll
                for (int j = 0; j < 4; ++j) { const int t = 16 * tq + t4 + j;
                    QE[t * 136 + d] = f2bf(bf2f(qr[t4 + j]) * 0.08838834764831845f * __expf(bb[j])); KE[t * 136 + d] = f2bf(kk[j] * __expf(-bb[j])); } } }
        LBAR();
        unsigned g_t1 = 0; if (PROBE_G && OUT && nvalid == 64 && blockIdx.x == 0 && tid == 0) { g_t1 = (unsigned)__builtin_amdgcn_s_memrealtime(); gts[0] += g_t1 - g_t0; }
        if (!OUT) { const int tnext = (ck + 1 < nchunks) ? tok0 + 64 : tok0; GLA_LOAD(tnext); }
        if (OUT) {
            if (w < 3) { const int jb = (w == 2) ? 1 : 0, ib = (w == 0) ? 0 : 1;
                f32x16 a = {0.f, 0.f, 0.f, 0.f, 0.f, 0.f, 0.f, 0.f, 0.f, 0.f, 0.f, 0.f, 0.f, 0.f, 0.f, 0.f};
#pragma unroll
                for (int ks = 0; ks < 8; ++ks) { const bf16x8 A = *(const LAS bf16x8*)(KE + (32 * jb + r) * 136 + 16 * ks + 8 * hh), B = *(const LAS bf16x8*)(QE + (32 * ib + r) * 136 + 16 * ks + 8 * hh);
                    a = MFMA32(A, B, a); }
                const int i = 32 * ib + r;
#pragma unroll
                for (int g = 0; g < 4; ++g) { const int j0 = 32 * jb + 8 * g + 4 * hh; float e[4];
#pragma unroll
                    for (int q = 0; q < 4; ++q) e[q] = (j0 + q <= i) ? a[4 * g + q] : 0.f;
                    *(LAS u32x2*)(SC + i * 72 + j0) = (u32x2){cvt_pk_bf16(e[0], e[1]), cvt_pk_bf16(e[2], e[3])}; }
            } else if (w == 3) {
#pragma unroll
                for (int g = 0; g < 4; ++g) *(LAS u32x2*)(SC + r * 72 + 32 + 8 * g + 4 * hh) = (u32x2){0u, 0u};
            }
            LBAR();
        }
        u32x2 gg[2][4];
        if (OUT) {
#pragma unroll
            for (int ib = 0; ib < 2; ++ib) { const int t = 32 * ib + r; const bf16_t* gp = zg + (size_t)(tok0 + (t < nvalid ? t : 0)) * 1024 + h * 256 + 32 * w + 4 * hh;
#pragma unroll
                for (int g = 0; g < 4; ++g) gg[ib][g] = *(const u32x2*)(gp + 8 * g); } }
        bf16x8 vf[4];
#pragma unroll
        for (int ks = 0; ks < 4; ++ks) vf[ks] = *(const LAS bf16x8*)(VT + (32 * w + r) * 72 + 16 * ks + 8 * hh);
        f32x16 oT[2];
        if (OUT) {
#pragma unroll
            for (int ib = 0; ib < 2; ++ib)
#pragma unroll
                for (int g = 0; g < 16; ++g) oT[ib][g] = 0.f;
#pragma unroll
            for (int db = 0; db < 4; ++db)
#pragma unroll
                for (int s = 0; s < 2; ++s) {
                    u32x4 ap; ap.x = cvt_pk_bf16(S[db][8 * s + 0], S[db][8 * s + 1]); ap.y = cvt_pk_bf16(S[db][8 * s + 2], S[db][8 * s + 3]);
                    ap.z = cvt_pk_bf16(S[db][8 * s + 4], S[db][8 * s + 5]); ap.w = cvt_pk_bf16(S[db][8 * s + 6], S[db][8 * s + 7]);
                    const bf16x8 A = __builtin_bit_cast(bf16x8, ap);
#pragma unroll
                    for (int ib = 0; ib < 2; ++ib) { const int i = 32 * ib + r;
                        const u32x2 lo = *(const LAS u32x2*)(QE + i * 136 + 32 * db + 16 * s + 4 * hh), hi = *(const LAS u32x2*)(QE + i * 136 + 32 * db + 16 * s + 8 + 4 * hh);
                        const u32x4 bp = (u32x4){lo.x, lo.y, hi.x, hi.y};
                        oT[ib] = MFMA32(A, __builtin_bit_cast(bf16x8, bp), oT[ib]); }
                    __builtin_amdgcn_sched_barrier(0); }
#pragma unroll
            for (int ks = 0; ks < 4; ++ks)
#pragma unroll
                for (int ib = 0; ib < 2; ++ib) { const bf16x8 B = *(const LAS bf16x8*)(SC + (32 * ib + r) * 72 + 16 * ks + 8 * hh); oT[ib] = MFMA32(vf[ks], B, oT[ib]); }
            __builtin_amdgcn_sched_barrier(0);
        }
#pragma unroll
        for (int db = 0; db < 4; ++db) {
#pragma unroll
            for (int g = 0; g < 4; ++g) { const f32x4 e = *(const LAS f32x4*)(EDEC + 32 * db + 8 * g + 4 * hh);
                S[db][4 * g + 0] *= e[0]; S[db][4 * g + 1] *= e[1]; S[db][4 * g + 2] *= e[2]; S[db][4 * g + 3] *= e[3]; }
#pragma unroll
            for (int ks = 0; ks < 4; ++ks) { const bf16x8 A = *(const LAS bf16x8*)(KLT + (32 * db + r) * 72 + 16 * ks + 8 * hh); S[db] = MFMA32(A, vf[ks], S[db]); }
            __builtin_amdgcn_sched_barrier(0);
        }
        if (OUT) { const int tnext = (ck + 1 < nchunks) ? tok0 + 64 : tok0; GLA_LOAD(tnext); }
        if (OUT) {
#pragma unroll
            for (int ib = 0; ib < 2; ++ib) { float ss = 0.f;
#pragma unroll
                for (int g = 0; g < 16; ++g) ss += oT[ib][g] * oT[ib][g];
                ss += __shfl_xor(ss, 32);
                if (hh == 0) PART[w * 64 + 32 * ib + r] = ss; }
            LBAR();
#pragma unroll
            for (int ib = 0; ib < 2; ++ib) { const int t = 32 * ib + r; float tot = 0.f;
#pragma unroll
                for (int q = 0; q < 8; ++q) tot += PART[q * 64 + t];
                const float rstd = rsqrtf(tot * (1.0f / 256.0f) + EPS);
                if (t < nvalid) { bf16_t* gp = zg + (size_t)(tok0 + t) * 1024 + h * 256 + 32 * w + 4 * hh;
#pragma unroll
                    for (int g = 0; g < 4; ++g) { const f32x4 gn = *(const LAS f32x4*)(GN + 32 * w + 8 * g + 4 * hh);
                        const float g0 = bf_lo(gg[ib][g].x), g1 = bf_hi(gg[ib][g].x), g2 = bf_lo(gg[ib][g].y), g3 = bf_hi(gg[ib][g].y);
                        const float o0 = oT[ib][4 * g + 0] * rstd * gn[0] * g0 * __builtin_amdgcn_rcpf(1.0f + __expf(-g0));
                        const float o1 = oT[ib][4 * g + 1] * rstd * gn[1] * g1 * __builtin_amdgcn_rcpf(1.0f + __expf(-g1));
                        const float o2 = oT[ib][4 * g + 2] * rstd * gn[2] * g2 * __builtin_amdgcn_rcpf(1.0f + __expf(-g2));
                        const float o3 = oT[ib][4 * g + 3] * rstd * gn[3] * g3 * __builtin_amdgcn_rcpf(1.0f + __expf(-g3));
                        *(u32x2*)(gp + 8 * g) = (u32x2){cvt_pk_bf16(o0, o1), cvt_pk_bf16(o2, o3)}; } } }
        }
        LBAR();
        if (PROBE_G && OUT && nvalid == 64 && blockIdx.x == 0 && tid == 0) gts[1] += (unsigned)__builtin_amdgcn_s_memrealtime() - g_t1;
    }
    if (Sfinal) { float* sp = Sfinal + (size_t)(4 * hh) * 256 + 32 * w + r;
#pragma unroll
        for (int db = 0; db < 4; ++db)
#pragma unroll
            for (int q4 = 0; q4 < 4; ++q4) { float* p = sp + (size_t)(32 * db + 8 * q4) * 256; asm volatile("" : "+v"(p));
                p[0] = S[db][4 * q4 + 0]; p[256] = S[db][4 * q4 + 1]; p[512] = S[db][4 * q4 + 2]; p[768] = S[db][4 * q4 + 3]; } }
    if (Dout && tq == 0) Dout[d] = __expf(dsum);
}


#undef GLA_LOAD
#undef GLA_LOADK
__device__ __forceinline__ f32x4 small_tile(LAS unsigned char* lds, const bf16_t* A, const bf16_t* Bt, int K, int row0, int col0) {
    const int tid = opaque_tid(), lane = tid & 63, w = __builtin_amdgcn_readfirstlane(tid >> 6), r = lane & 31, hh = lane >> 5;
    const int ksl = K >> 3;
    const bf16_t* ap = A + (size_t)(row0 + r) * K + w * ksl + 8 * hh;
    const bf16_t* b0 = Bt + (size_t)(col0 + r) * K + w * ksl + 8 * hh; const bf16_t* b1 = b0 + (size_t)32 * K;
    f32x16 c0, c1;
#pragma unroll
    for (int g = 0; g < 16; ++g) { c0[g] = 0.f; c1[g] = 0.f; }
    const int nks = ksl >> 4;
#pragma unroll 2
    for (int ks = 0; ks < nks; ++ks) { const bf16x8 a = *(const bf16x8*)(ap + 16 * ks), x = *(const bf16x8*)(b0 + 16 * ks), y = *(const bf16x8*)(b1 + 16 * ks);
        c0 = MFMA32(a, x, c0); c1 = MFMA32(a, y, c1); }
    LAS float* RED = (LAS float*)lds;
#pragma unroll
    for (int g = 0; g < 16; ++g) { const int row = (g & 3) + 8 * (g >> 2) + 4 * hh; RED[(w * 32 + row) * 64 + r] = c0[g]; RED[(w * 32 + row) * 64 + 32 + r] = c1[g]; }
    __syncthreads();
    const int row = tid >> 4, c4 = (tid & 15) * 4; f32x4 sum = (f32x4){0.f, 0.f, 0.f, 0.f};
#pragma unroll
    for (int q = 0; q < 8; ++q) sum += *(const LAS f32x4*)(RED + (q * 32 + row) * 64 + c4);
    __syncthreads();
    return sum;
}

#define XB_TMO      128
#define XB_XCNT(j)  (256  + 64 * (j))
#define XB_XSUB(j)  (1280 + 64 * (j))
#define XB_XGEN(j)  (2304 + 64 * (j))
#define XB_TOP      3328
#define XB_TOPGEN   3392
#define XCD_BAR_WORDS 3456
#define XB_SPIN_CAP (1u << 22)
__device__ __forceinline__ unsigned xb_ld(unsigned* p)              { return __hip_atomic_load(p, __ATOMIC_RELAXED, __HIP_MEMORY_SCOPE_AGENT); }
__device__ __forceinline__ unsigned xb_add(unsigned* p, unsigned v) { return __hip_atomic_fetch_add(p, v, __ATOMIC_RELAXED, __HIP_MEMORY_SCOPE_AGENT); }
__device__ __forceinline__ unsigned xb_xcc_id() { return (unsigned)__builtin_amdgcn_s_getreg((3 << 11) | 20) & 0xFu; }
#define XB_SPIN(cond, bar) do { unsigned _sp = 0; while (cond) { __builtin_amdgcn_s_sleep(1); \
    if ((++_sp & 255u) == 0u) { if (xb_ld(&(bar)[XB_TMO])) break; if (_sp > XB_SPIN_CAP) { atomicAdd(&(bar)[XB_TMO], 1u); break; } } } } while (0)
struct XcdBarrier { unsigned* bar; unsigned x; volatile LAS unsigned* st; };
__device__ __forceinline__ XcdBarrier xcd_barrier_post(unsigned* bar, volatile LAS unsigned* st) {
    XcdBarrier b; b.bar = bar; b.x = xb_xcc_id(); b.st = st;
    if (threadIdx.x == 0) (void)xb_add(&bar[XB_XCNT(b.x)], 1u);
    return b;
}
__device__ __forceinline__ void xcd_barrier_complete(unsigned* bar, unsigned x, unsigned& nloc, unsigned& nx) {
    const unsigned G = gridDim.x * gridDim.y * gridDim.z;
    unsigned sum, cnt, mine, sp = 0u;
    for (;;) {
        sum = 0u; cnt = 0u; mine = 0u;
#pragma unroll
        for (unsigned j = 0; j < 16; ++j) { const unsigned c = xb_ld(&bar[XB_XCNT(j)]); sum += c; cnt += (c > 0u) ? 1u : 0u; mine = (j == x) ? c : mine; }
        if (sum == G) break;
        __builtin_amdgcn_s_sleep(1);
        if ((++sp & 255u) == 0u) { if (xb_ld(&bar[XB_TMO])) break; if (sp > XB_SPIN_CAP) { atomicAdd(&bar[XB_TMO], 1u); break; } }
    }
    nloc = mine > 0u ? mine : 1u; nx = cnt > 0u ? cnt : 1u;
}
__device__ __forceinline__ void xcd_barrier(const XcdBarrier& b) {
    asm volatile("s_waitcnt vmcnt(0)" ::: "memory");
    __syncthreads();
    if (threadIdx.x == 0) {
        unsigned* bar = b.bar;
        __builtin_amdgcn_s_waitcnt(0);
        unsigned nloc = b.st[0], nx = b.st[1];
        if (nloc == 0u) { xcd_barrier_complete(bar, b.x, nloc, nx); b.st[0] = nloc; b.st[1] = nx; }
        const unsigned old = xb_add(&bar[XB_XSUB(b.x)], 1u);
        const unsigned gen = old / nloc;
        if (old + 1u == (gen + 1u) * nloc) {
            __builtin_amdgcn_fence(__ATOMIC_RELEASE, "agent");
            asm volatile("s_waitcnt vmcnt(0)" ::: "memory");
            const unsigned og = xb_add(&bar[XB_TOP], 1u);
            const unsigned tg = og / nx;
            if (og + 1u == (tg + 1u) * nx) xb_add(&bar[XB_TOPGEN], 1u);
            else XB_SPIN(xb_ld(&bar[XB_TOPGEN]) == tg, bar);
            __builtin_amdgcn_fence(__ATOMIC_ACQUIRE, "agent");
            xb_add(&bar[XB_XGEN(b.x)], 1u);
            asm volatile("s_waitcnt vmcnt(0)" ::: "memory");
        } else {
            XB_SPIN(xb_ld(&bar[XB_XGEN(b.x)]) == gen, bar);
            __builtin_amdgcn_fence(__ATOMIC_ACQUIRE, "agent");
            asm volatile("s_waitcnt vmcnt(0)" ::: "memory");
        }
    }
    __syncthreads();
}

__device__ __forceinline__ void cnt_publish(unsigned* c) {
    asm volatile("s_waitcnt vmcnt(0)" ::: "memory"); __syncthreads();
    if (threadIdx.x == 0) { __builtin_amdgcn_fence(__ATOMIC_RELEASE, "agent"); asm volatile("s_waitcnt vmcnt(0)" ::: "memory"); (void)__hip_atomic_fetch_add(c, 1u, __ATOMIC_RELAXED, __HIP_MEMORY_SCOPE_AGENT); }
}
__device__ __forceinline__ void cnt_wait(unsigned* c, unsigned n) {
    if (threadIdx.x == 0) { unsigned sp = 0u;
        while (__hip_atomic_load(c, __ATOMIC_RELAXED, __HIP_MEMORY_SCOPE_AGENT) < n) { __builtin_amdgcn_s_sleep(2); if (++sp > (1u << 22)) break; }
        __builtin_amdgcn_fence(__ATOMIC_ACQUIRE, "agent"); asm volatile("s_waitcnt vmcnt(0)" ::: "memory"); }
    __syncthreads();
}
__device__ __forceinline__ void final_norm_row(float* x, const float* gamma, int row, int lane) {
    float* xp = x + (size_t)row * 1024; f32x4 v[4]; float ss = 0.f;
#pragma unroll
    for (int i = 0; i < 4; ++i) v[i] = *(const f32x4*)(xp + i * 256 + lane * 4);
#pragma unroll
    for (int i = 0; i < 4; ++i) ss += v[i][0] * v[i][0] + v[i][1] * v[i][1] + v[i][2] * v[i][2] + v[i][3] * v[i][3];
#pragma unroll
    for (int o = 32; o >= 1; o >>= 1) ss += __shfl_xor(ss, o);
    const float rstd = rsqrtf(ss * (1.0f / 1024.0f) + EPS);
#pragma unroll
    for (int i = 0; i < 4; ++i) { const f32x4 g = *(const f32x4*)(gamma + i * 256 + lane * 4); *(f32x4*)(xp + i * 256 + lane * 4) = v[i] * rstd * g; }
}

__device__ __forceinline__ void norm_mod_row(const float* x, const float* gamma, const float* mod, int sh_off, int sc_off, bf16_t* H, int row, int lane) {
    const float* xp = x + (size_t)row * 1024; f32x4 v[4]; float ss = 0.f;
#pragma unroll
    for (int i = 0; i < 2; ++i) { v[2 * i] = *(const f32x4*)(xp + i * 512 + lane * 8); v[2 * i + 1] = *(const f32x4*)(xp + i * 512 + lane * 8 + 4); }
#pragma unroll
    for (int i = 0; i < 4; ++i) ss += v[i][0] * v[i][0] + v[i][1] * v[i][1] + v[i][2] * v[i][2] + v[i][3] * v[i][3];
#pragma unroll
    for (int o = 32; o >= 1; o >>= 1) ss += __shfl_xor(ss, o);
    const float rstd = rsqrtf(ss * (1.0f / 1024.0f) + EPS);
    const float* mp = mod + (size_t)modrow_of(row) * NMOD;
#pragma unroll
    for (int i = 0; i < 2; ++i) { const int c = i * 512 + lane * 8; float o[8];
#pragma unroll
        for (int hlf = 0; hlf < 2; ++hlf) { const f32x4 g = *(const f32x4*)(gamma + c + 4 * hlf), sc = *(const f32x4*)(mp + sc_off + c + 4 * hlf), sh = *(const f32x4*)(mp + sh_off + c + 4 * hlf);
#pragma unroll
            for (int j = 0; j < 4; ++j) o[4 * hlf + j] = v[2 * i + hlf][j] * rstd * g[j] * (1.0f + sc[j]) + sh[j]; }
        u32x4 w; w.x = cvt_pk_bf16(o[0], o[1]); w.y = cvt_pk_bf16(o[2], o[3]); w.z = cvt_pk_bf16(o[4], o[5]); w.w = cvt_pk_bf16(o[6], o[7]);
        *(u32x4*)(H + (size_t)row * 1024 + c) = w; }
}

__global__ void __launch_bounds__(512, 2) fwd_megakernel(Params P) {
    extern __shared__ __attribute__((aligned(16))) unsigned char lds_raw[];
    LAS unsigned char* lds = (LAS unsigned char*)lds_raw;
    cg::grid_group grid = cg::this_grid();
    const int G = gridDim.x, bid = blockIdx.x, tid = threadIdx.x;
    unsigned char* ws = P.ws;
    float* mod = (float*)(ws + WS_MOD);
    bf16_t* Hb = (bf16_t*)(ws + WS_H);
    bf16_t* Rg = (bf16_t*)P.out;
    bf16_t* Gg = Rg + (size_t)MTOT * 1024;
    volatile LAS unsigned* xst = (volatile LAS unsigned*)(lds + LDS_BYTES - 16);
    if (tid < 4) xst[tid] = 0u;
    if (tid < 32) ((volatile LAS unsigned*)(lds + LDS_BYTES - 128))[tid] = 0u;
    __syncthreads();
    const XcdBarrier xbar = xcd_barrier_post((unsigned*)(ws + WS_BAR), xst);
    if (P.ws == nullptr) grid.sync();
#ifndef PROBE_T
#define PROBE_T -1
#endif
#ifndef PROBE_T2
#define PROBE_T2 (PROBE_T + 1)
#endif
    volatile LAS unsigned* tsL = (volatile LAS unsigned*)(lds + LDS_BYTES - 128);
    int nts = 0;
#define STAMP() do { if (PROBE_T >= 0) { if (bid == 0 && tid == 0) tsL[nts] = (unsigned)__builtin_amdgcn_s_memrealtime(); ++nts; } } while (0)
#define GRID_SYNC() do { xcd_barrier(xbar); STAMP(); } while (0)
    STAMP();

#ifndef PHMASK
#define PHMASK 0xffff
#endif
#define PH(n) if ((PHMASK >> (n)) & 1)
    PH(0) phase0(P, lds);
    if (PROBE_P0) { __syncthreads(); phase0(P, lds); }
    for (int q = 0; q < PROBE_SYNC; ++q) GRID_SYNC();
    GRID_SYNC();
    PH(1) phase_norm_mod(P.in[0], P.in[1], P.in[8], mod, 0, 1024, Hb);
    if (PROBE_NORM) phase_norm_mod(P.in[0], P.in[1], P.in[8], mod, 0, 1024, Hb);
    GRID_SYNC();
    PH(2) { pg8::Gemm g{Hb, (const bf16_t*)(ws + WS_WIN), 1024}; pg8::Order S; S.init(66, 33, G, bid, 0, 0, 0, WGM_BIG);
      EpiIn E{ws, Rg, Gg}; pg8::gemm_phase<EpiIn>(lds, g, S, E); if (PROBE_DUP) pg8::gemm_phase<EpiIn>(lds, g, S, E); }
    GRID_SYNC();
    if (PROBE_GLA1) for (int it = bid; it < 240; it += G) { const int bh = it / 15, seg = it % 15, b = bh >> 2, h = bh & 3;
            gla_walk<false>(P, lds, h, b * 4096 + seg * (SEGCH * 64), SEGCH, 64, nullptr, (float*)(ws + SEG_STATE) + (size_t)(bh * 16 + seg) * 32768, (float*)(ws + SEG_DEC) + (size_t)(bh * 16 + seg) * 128); }
    PH(3) for (int it = bid; it < 304; it += G) {
        if (it < 240) { const int bh = it / 15, seg = it % 15, b = bh >> 2, h = bh & 3;
            gla_walk<false>(P, lds, h, b * 4096 + seg * (SEGCH * 64), SEGCH, 64, nullptr, (float*)(ws + SEG_STATE) + (size_t)(bh * 16 + seg) * 32768, (float*)(ws + SEG_DEC) + (size_t)(bh * 16 + seg) * 128);
        } else { const int sbh = it - 240, sb = sbh >> 2, h = sbh & 3;
            gla_walk<true>(P, lds, h, MP + sb * 32, 1, 32, P.in[4] + (size_t)sbh * 32768, P.out + O_SS + (size_t)sbh * 32768, nullptr); }
    }
    PH(4) { if (G == 256) { if (bid >= 48) for (int blk = bid - 48; blk < 264; blk += 208) conv_block(P, blk); }
            else for (int blk = bid; blk < 264; blk += G) conv_block(P, blk); }
    GRID_SYNC();
    for (int e4 = bid * 512 + tid; e4 < 16 * 8192; e4 += G * 512) { const int bh = e4 >> 13, idx = (e4 & 8191) * 4, dd = idx >> 8;
        float* lp = (float*)(ws + SEG_STATE) + (size_t)(bh * 16) * 32768 + idx; const float* dp = (const float*)(ws + SEG_DEC) + (bh * 16) * 128 + dd;
        f32x4 L[15]; float dc[15];
#pragma unroll
        for (int seg = 0; seg < 15; ++seg) { L[seg] = *(const f32x4*)(lp + (size_t)seg * 32768); dc[seg] = dp[seg * 128]; }
        f32x4 s = (f32x4){0.f, 0.f, 0.f, 0.f};
#pragma unroll
        for (int seg = 0; seg < 15; ++seg) { s = s * dc[seg] + L[seg]; *(f32x4*)(lp + (size_t)seg * 32768) = s; } }
    GRID_SYNC();
    PH(5) for (int it = bid; it < 256; it += G) { const int bh = it >> 4, seg = it & 15, b = bh >> 2, h = bh & 3;
        gla_walk<true>(P, lds, h, b * 4096 + seg * (SEGCH * 64), SEGCH, 64, seg ? (const float*)(ws + SEG_STATE) + (size_t)(bh * 16 + seg - 1) * 32768 : nullptr,
                       seg == 15 ? P.out + O_SP + (size_t)bh * 32768 : nullptr, nullptr); }
    GRID_SYNC();
    PH(6) { pg8::Gemm g{(const bf16_t*)(ws + Z_G), (const bf16_t*)(ws + WS_WGC), 1024}; pg8::Order S; S.init(64, 4, G, bid, 1, 66, 4);
      const bool small_first = (bid & 1) != 0;
      if (small_first) {
      for (int tl = bid; tl < 256; tl += G) { const int row0 = MP + (tl >> 4) * 32, col0 = (tl & 15) * 64;
          const f32x4 ya = small_tile(lds, (const bf16_t*)(ws + Z_G), (const bf16_t*)(ws + WS_WGC), 1024, row0, col0);
          const f32x4 yb = small_tile(lds, (const bf16_t*)(ws + Z_CB), (const bf16_t*)(ws + WS_WGC) + (size_t)1024 * 1024, 1024, row0, col0);
          const size_t o = (size_t)(row0 + (tid >> 4)) * 1024 + col0 + (tid & 15) * 4;
          const u32x2 rr = *(const u32x2*)(Rg + o), gg = *(const u32x2*)(Gg + o);
          const float m0 = bf_lo(gg.x) * (bf_lo(rr.x) * ya[0] + yb[0]), m1 = bf_hi(gg.x) * (bf_hi(rr.x) * ya[1] + yb[1]);
          const float m2 = bf_lo(gg.y) * (bf_lo(rr.y) * ya[2] + yb[2]), m3 = bf_hi(gg.y) * (bf_hi(rr.y) * ya[3] + yb[3]);
          *(u32x2*)((bf16_t*)(ws + Z_V) + o) = (u32x2){cvt_pk_bf16(m0, m1), cvt_pk_bf16(m2, m3)}; }
      }
      EpiMerge E{Rg, Gg, (bf16_t*)(ws + Z_V)}; pg8::gemm_phase<EpiMerge>(lds, g, S, E); if (PROBE_DUP) pg8::gemm_phase<EpiMerge>(lds, g, S, E);
      if (!small_first) {
      for (int tl = bid; tl < 256; tl += G) { const int row0 = MP + (tl >> 4) * 32, col0 = (tl & 15) * 64;
          const f32x4 ya = small_tile(lds, (const bf16_t*)(ws + Z_G), (const bf16_t*)(ws + WS_WGC), 1024, row0, col0);
          const f32x4 yb = small_tile(lds, (const bf16_t*)(ws + Z_CB), (const bf16_t*)(ws + WS_WGC) + (size_t)1024 * 1024, 1024, row0, col0);
          const size_t o = (size_t)(row0 + (tid >> 4)) * 1024 + col0 + (tid & 15) * 4;
          const u32x2 rr = *(const u32x2*)(Rg + o), gg = *(const u32x2*)(Gg + o);
          const float m0 = bf_lo(gg.x) * (bf_lo(rr.x) * ya[0] + yb[0]), m1 = bf_hi(gg.x) * (bf_hi(rr.x) * ya[1] + yb[1]);
          const float m2 = bf_lo(gg.y) * (bf_lo(rr.y) * ya[2] + yb[2]), m3 = bf_hi(gg.y) * (bf_hi(rr.y) * ya[3] + yb[3]);
          *(u32x2*)((bf16_t*)(ws + Z_V) + o) = (u32x2){cvt_pk_bf16(m0, m1), cvt_pk_bf16(m2, m3)}; }
      } }
    GRID_SYNC();
    if (G == 256) {
        pg8::Gemm g{(const bf16_t*)(ws + Z_V), (const bf16_t*)(ws + WS_WO), 1024}; pg8::Order S; S.init(64, 4, G, bid);
        unsigned* cnt = (unsigned*)(ws + WS_CNT) + 64 * 80; const int rbk = bid >> 4, cbk = bid & 15;
        const bool small_first = (bid & 1) != 0;
#define P5_SMALL() do { const int row0 = MP + rbk * 32, col0 = cbk * 64; \
            const f32x4 a = small_tile(lds, (const bf16_t*)(ws + Z_V), (const bf16_t*)(ws + WS_WO), 1024, row0, col0); \
            const int row = row0 + (tid >> 4), col = col0 + (tid & 15) * 4; \
            const f32x4 xb = *(const f32x4*)(P.in[1] + (size_t)(row - MP) * 1024 + col), gt = *(const f32x4*)(mod + 2048 + (size_t)modrow_of(row) * NMOD + col); \
            *(f32x4*)(P.out + (size_t)row * 1024 + col) = xb + gt * a; cnt_publish(cnt + 64 * (64 + rbk)); } while (0)
        if (small_first) P5_SMALL();
        { EpiResNormMod E{P.in[0], P.out, Hb, mod, P.in[18], (float*)(ws + WS_RSS2), cnt}; pg8::gemm_phase<EpiResNormMod>(lds, g, S, E); }
        if (!small_first) P5_SMALL();
#undef P5_SMALL
        cnt_wait(cnt + 64 * (64 + rbk), 16u);
        { const int t_ = opaque_tid(), lane = t_ & 63, wid = t_ >> 6; if (wid < 2) norm_mod_row(P.out, P.in[18], mod, 3072, 4096, Hb, MP + 32 * rbk + 2 * cbk + wid, lane); }
        GRID_SYNC();
    } else {
        PH(7) { pg8::Gemm g{(const bf16_t*)(ws + Z_V), (const bf16_t*)(ws + WS_WO), 1024}; pg8::Order S; S.init(64, 4, G, bid);
          const bool small_first = (bid & 1) != 0;
          if (small_first) {
          for (int tl = bid; tl < 256; tl += G) { const int row0 = MP + (tl >> 4) * 32, col0 = (tl & 15) * 64;
              const f32x4 a = small_tile(lds, (const bf16_t*)(ws + Z_V), (const bf16_t*)(ws + WS_WO), 1024, row0, col0);
              const int row = row0 + (tid >> 4), col = col0 + (tid & 15) * 4;
              const f32x4 xb = *(const f32x4*)(P.in[1] + (size_t)(row - MP) * 1024 + col), gt = *(const f32x4*)(mod + 2048 + (size_t)modrow_of(row) * NMOD + col);
              *(f32x4*)(P.out + (size_t)row * 1024 + col) = xb + gt * a; }
          }
          EpiRes E{P.in[0], P.in[1], P.out, mod + 2048}; pg8::gemm_phase<EpiRes>(lds, g, S, E); if (PROBE_DUP) pg8::gemm_phase<EpiRes>(lds, g, S, E);
          if (!small_first) {
          for (int tl = bid; tl < 256; tl += G) { const int row0 = MP + (tl >> 4) * 32, col0 = (tl & 15) * 64;
              const f32x4 a = small_tile(lds, (const bf16_t*)(ws + Z_V), (const bf16_t*)(ws + WS_WO), 1024, row0, col0);
              const int row = row0 + (tid >> 4), col = col0 + (tid & 15) * 4;
              const f32x4 xb = *(const f32x4*)(P.in[1] + (size_t)(row - MP) * 1024 + col), gt = *(const f32x4*)(mod + 2048 + (size_t)modrow_of(row) * NMOD + col);
              *(f32x4*)(P.out + (size_t)row * 1024 + col) = xb + gt * a; }
          } }
        GRID_SYNC();
        PH(8) phase_norm_mod(P.out, P.out + (size_t)MP * 1024, P.in[18], mod, 3072, 4096, Hb);
        GRID_SYNC();
    }
    PH(9) { pg8::Gemm g{Hb, (const bf16_t*)(ws + WS_WF1), 1024}; pg8::Order S; S.init(66, 22, G, bid, 0, 0, 0, WGM_BIG);
      EpiAct E{(bf16_t*)(ws + WS_Z)}; pg8::gemm_phase<EpiAct>(lds, g, S, E); if (PROBE_DUP) pg8::gemm_phase<EpiAct>(lds, g, S, E); }
    GRID_SYNC();
    if (G == 256) {
        pg8::Gemm g{(const bf16_t*)(ws + WS_Z), (const bf16_t*)(ws + WS_WF2), DFF}; pg8::Order S; S.init(64, 4, G, bid);
        unsigned* cnt = (unsigned*)(ws + WS_CNT); const int rbk = bid >> 4, cbk = bid & 15;
        const bool small_first = (bid & 1) != 0;
#define P8_SMALL() do { const int row0 = MP + rbk * 32, col0 = cbk * 64; \
            const f32x4 a = small_tile(lds, (const bf16_t*)(ws + WS_Z), (const bf16_t*)(ws + WS_WF2), DFF, row0, col0); \
            const int row = row0 + (tid >> 4), col = col0 + (tid & 15) * 4; float* op = P.out + (size_t)row * 1024 + col; \
            const f32x4 xb = *(const f32x4*)op, gt = *(const f32x4*)(mod + 5120 + (size_t)modrow_of(row) * NMOD + col); \
            *(f32x4*)op = xb + gt * a; cnt_publish(cnt + 64 * (64 + rbk)); } while (0)
        if (small_first) P8_SMALL();
        { EpiResNorm E{P.out, P.out, mod + 5120, P.in[21], (float*)(ws + WS_RSS), cnt}; pg8::gemm_phase<EpiResNorm>(lds, g, S, E); }
        if (!small_first) P8_SMALL();
#undef P8_SMALL
        cnt_wait(cnt + 64 * (64 + rbk), 16u);
        { const int t_ = opaque_tid(), lane = t_ & 63, wid = t_ >> 6; if (wid < 2) final_norm_row(P.out, P.in[21], MP + 32 * rbk + 2 * cbk + wid, lane); }
    } else {
        PH(10) { pg8::Gemm g{(const bf16_t*)(ws + WS_Z), (const bf16_t*)(ws + WS_WF2), DFF}; pg8::Order S; S.init(64, 4, G, bid);
          const bool small_first = (bid & 1) != 0;
          if (small_first) {
          for (int tl = bid; tl < 256; tl += G) { const int row0 = MP + (tl >> 4) * 32, col0 = (tl & 15) * 64;
              const f32x4 a = small_tile(lds, (const bf16_t*)(ws + WS_Z), (const bf16_t*)(ws + WS_WF2), DFF, row0, col0);
              const int row = row0 + (tid >> 4), col = col0 + (tid & 15) * 4;
              float* op = P.out + (size_t)row * 1024 + col;
              const f32x4 xb = *(const f32x4*)op, gt = *(const f32x4*)(mod + 5120 + (size_t)modrow_of(row) * NMOD + col);
              *(f32x4*)op = xb + gt * a; }
          }
          EpiRes E{P.out, P.out + (size_t)MP * 1024, P.out, mod + 5120}; pg8::gemm_phase<EpiRes>(lds, g, S, E);
          if (!small_first) {
          for (int tl = bid; tl < 256; tl += G) { const int row0 = MP + (tl >> 4) * 32, col0 = (tl & 15) * 64;
              const f32x4 a = small_tile(lds, (const bf16_t*)(ws + WS_Z), (const bf16_t*)(ws + WS_WF2), DFF, row0, col0);
              const int row = row0 + (tid >> 4), col = col0 + (tid & 15) * 4;
              float* op = P.out + (size_t)row * 1024 + col;
              const f32x4 xb = *(const f32x4*)op, gt = *(const f32x4*)(mod + 5120 + (size_t)modrow_of(row) * NMOD + col);
              *(f32x4*)op = xb + gt * a; }
          } }
        GRID_SYNC();
        PH(11) phase_final_norm(P.out, P.in[21]);
    }
    if (PROBE_T >= 0) { STAMP(); if (bid == 0 && tid == 0) { const unsigned dt = PROBE_G ? tsL[13 + PROBE_G] : tsL[PROBE_T2] - tsL[PROBE_T]; const unsigned t0 = (unsigned)__builtin_amdgcn_s_memrealtime();
        while ((unsigned)__builtin_amdgcn_s_memrealtime() - t0 < 8u * dt) __builtin_amdgcn_s_sleep(8); } }
}

extern "C" void kernel_launch(void* const* d_in, const int* in_sizes, int n_in, void* d_out, int out_size, void* d_ws, size_t ws_size, hipStream_t stream) {
    static int grid_blocks = 0;
    if (grid_blocks == 0) {
        if (n_in != 22 || ws_size < WS_END) { fprintf(stderr, "kernel_launch: unexpected n_in %d / ws %zu (need %zu)\n", n_in, ws_size, (size_t)WS_END); grid_blocks = -1; return; }
        int dev = 0, cus = 0, per_cu = 0;
        hipGetDevice(&dev); hipDeviceGetAttribute(&cus, hipDeviceAttributeMultiprocessorCount, dev);
        if (hipFuncSetAttribute((const void*)fwd_megakernel, hipFuncAttributeMaxDynamicSharedMemorySize, LDS_BYTES) != hipSuccess) { fprintf(stderr, "kernel_launch: hipFuncSetAttribute failed\n"); grid_blocks = -1; return; }
        hipOccupancyMaxActiveBlocksPerMultiprocessor(&per_cu, (const void*)fwd_megakernel, 512, LDS_BYTES);
        (void)hipGetLastError();
        if (per_cu < 1) per_cu = 1;
        grid_blocks = cus;
        fprintf(stderr, "kernel_launch: cus %d per_cu %d grid %d\n", cus, per_cu, grid_blocks);
    }
    if (grid_blocks < 0) return;
    if (hipMemsetAsync((char*)d_ws + WS_MOD, 0, (size_t)NMODROW * NMOD * 4, stream) != hipSuccess) { fprintf(stderr, "kernel_launch: memset failed\n"); return; }
    if (hipMemsetAsync((char*)d_ws + WS_BAR, 0, WS_END - WS_BAR, stream) != hipSuccess) { fprintf(stderr, "kernel_launch: memset failed\n"); return; }
    Params p{};
    for (int i = 0; i < 22; ++i) p.in[i] = (const float*)d_in[i];
    p.out = (float*)d_out; p.ws = (unsigned char*)d_ws;
    void* args[] = {&p};
    hipError_t e = hipLaunchCooperativeKernel((const void*)fwd_megakernel, dim3(grid_blocks), dim3(512), args, LDS_BYTES, stream);
    if (e != hipSuccess) fprintf(stderr, "cooperative launch failed: %s (grid %d)\n", hipGetErrorString(e), grid_blocks);
}
```

```cpp
#include <hip/hip_runtime.h>
#include <hip/hip_cooperative_groups.h>
#include <cstdio>
#include <cstdint>
namespace cg = cooperative_groups;

#define LAS __attribute__((address_space(3)))
typedef unsigned short bf16_t;
typedef short bf16x8 __attribute__((ext_vector_type(8)));
typedef float f32x4 __attribute__((ext_vector_type(4)));
typedef float f32x16 __attribute__((ext_vector_type(16)));
typedef unsigned u32x4 __attribute__((ext_vector_type(4)));
typedef unsigned u32x2 __attribute__((ext_vector_type(2)));

constexpr int DM = 1024, MP = 16384, MTOT = 16896, NMODROW = 20, NMOD = 6144;
constexpr int NIN = 8448;
constexpr int DFF = 2816;
constexpr int NSEG = 16, SEGCH = 4;
constexpr float EPS = 1e-6f;

constexpr size_t WS_WIN = 0;
constexpr size_t WS_WGC = WS_WIN + (size_t)NIN * 1024 * 2;
constexpr size_t WS_WO  = WS_WGC + (size_t)2 * 1024 * 1024 * 2;
constexpr size_t WS_WF1 = WS_WO + (size_t)1024 * 1024 * 2;
constexpr size_t WS_WF2 = WS_WF1 + (size_t)5632 * 1024 * 2;
constexpr size_t WS_MOD = WS_WF2 + (size_t)1024 * 2816 * 2;
constexpr size_t WS_H   = WS_MOD + (size_t)NMODROW * NMOD * 4;
constexpr size_t WS_Z   = WS_H + (size_t)MTOT * 1024 * 2;
constexpr size_t Z_Q = WS_Z;
constexpr size_t Z_K = Z_Q + (size_t)MTOT * 512 * 2;
constexpr size_t Z_V = Z_K + (size_t)MTOT * 512 * 2;
constexpr size_t Z_G = Z_V + (size_t)MTOT * 1024 * 2;
constexpr size_t Z_CB = Z_G + (size_t)MTOT * 1024 * 2;
constexpr size_t Z_P = Z_CB + (size_t)MTOT * 1024 * 2;
constexpr size_t Z_A = Z_P + (size_t)MTOT * 1024 * 2;
constexpr size_t WS_BAR = Z_A + (size_t)MTOT * 256 * 2;
constexpr size_t WS_CNT = WS_BAR + 16384;
constexpr size_t WS_RSS = WS_CNT + 65536;
constexpr size_t WS_RSS2 = WS_RSS + 65536;
constexpr size_t WS_END = WS_RSS2 + 65536;
constexpr size_t SEG_STATE = WS_H;
constexpr size_t SEG_DEC = WS_H + (size_t)16 * 16 * 32768 * 4;
static_assert(SEG_DEC + 16 * 16 * 128 * 4 <= WS_Z, "seg state fits in H");
static_assert(WS_END <= (size_t)256 * 1024 * 1024, "ws");
constexpr size_t O_Y = 0, O_SP = 17301504, O_CP = 17825792, O_SS = 17833984, O_CS = 19931136;

constexpr int LDS_BYTES = 144 * 1024;
#ifndef WGM_BIG
#define WGM_BIG 4
#endif
#ifndef PROBE_DUP
#define PROBE_DUP 0
#endif
#ifndef PROBE_P0
#define PROBE_P0 0
#endif
#ifndef PROBE_NORM
#define PROBE_NORM 0
#endif
#ifndef PROBE_GLA1
#define PROBE_GLA1 0
#endif
#ifndef PROBE_SYNC
#define PROBE_SYNC 0
#endif

struct Params { const float* in[22]; float* out; unsigned char* ws; };

__device__ __forceinline__ unsigned cvt_pk_bf16(float lo, float hi) { unsigned r; asm("v_cvt_pk_bf16_f32 %0, %1, %2" : "=v"(r) : "v"(lo), "v"(hi)); return r; }
__device__ __forceinline__ float bf_lo(unsigned w) { return __uint_as_float(w << 16); }
__device__ __forceinline__ float bf_hi(unsigned w) { return __uint_as_float(w & 0xffff0000u); }
__device__ __forceinline__ float bf2f(bf16_t b) { return __uint_as_float(((unsigned)b) << 16); }
__device__ __forceinline__ bf16_t f2bf(float f) { return (bf16_t)(cvt_pk_bf16(f, 0.f) & 0xffffu); }
__device__ __forceinline__ float sigmoidf_(float x) { return 1.0f / (1.0f + __expf(-x)); }
__device__ __forceinline__ int opaque_tid() { int t = threadIdx.x; asm volatile("" : "+v"(t)); return t; }
__device__ __forceinline__ int modrow_of(int row) { return row < MP ? (row >> 12) : 4 + ((row - MP) >> 5); }

namespace pg8 {
constexpr int BM = 256, BK = 64, HALF = 128, HTB = HALF * BK * 2, STAGE_BYTES = 8 * HTB, NXCD = 8, WGM = 8;
__host__ __device__ __forceinline__ int lds_byte(int r, int c) { const int st = (r >> 4) * 2 + (c >> 5), rr = r & 15, cc = c & 31, ob = rr * 64 + cc * 2; return st * 1024 + (ob ^ (((ob >> 9) & 1) << 5)); }
__host__ __device__ __forceinline__ void stage_rc(int b, int& R, int& C) { const int st = b / 1024, sb = b % 1024, swz = sb ^ (((sb >> 9) & 1) << 5); R = (st >> 1) * 16 + swz / 64; C = (st & 1) * 32 + (swz % 64) / 2; }
__host__ __device__ __forceinline__ int perm32(int rho) { const int n = rho >> 4, i = rho & 15; return 8 * (i >> 2) + 4 * n + (i & 3); }

struct Unit { int pm, pn; };
struct Gemm { const bf16_t* A; const bf16_t* Bt; int K; };

struct Order {
    int nM, nN, nwg, G, c, paired, dpm, dpn, wgm;
    __device__ void init(int nM_, int nN_, int G_, int c_, int paired_ = 0, int dpm_ = 0, int dpn_ = 0, int wgm_ = WGM) { nM = nM_; nN = nN_; nwg = nM * nN; G = G_; c = c_; paired = paired_; dpm = dpm_; dpn = dpn_; wgm = wgm_; }
    __device__ bool next(int i, Unit& u) const {
        const int it = paired ? (i >> 1) : i;
        const long L = (long)it * G + c; if (L >= nwg) return false;
        int wgid = (int)L; { const int q = nwg / NXCD, r = nwg % NXCD, xcd = wgid % NXCD, off = wgid / NXCD; wgid = (xcd < r ? xcd * (q + 1) : r * (q + 1) + (xcd - r) * q) + off; }
        const int nig = wgm * nN, gid = wgid / nig, fm = gid * wgm, gsz = (nM - fm) < wgm ? (nM - fm) : wgm;
        u.pm = fm + ((wgid % nig) % gsz); u.pn = (wgid % nig) / gsz;
        if (paired && (i & 1)) { u.pm += dpm; u.pn += dpn; }
        return true;
    }
};

template <class Epi>
__device__ __forceinline__ void gemm_phase(LAS unsigned char* lds, const Gemm g, const Order& S, const Epi& E) {
    const int tid = opaque_tid(), wid = __builtin_amdgcn_readfirstlane(tid >> 6), lane = tid & 63, wr = wid >> 2, wc = wid & 3, fr = lane & 15, fq = lane >> 4;
    const int K = g.K, nt = K / BK;
    unsigned voffA[2], voffB[2];
#pragma unroll
    for (int i = 0; i < 2; ++i) { int R, C; stage_rc(tid * 16 + i * 8192, R, C); const int Rb = Epi::PERM ? ((R & ~31) + perm32(R & 31)) : R;
        voffA[i] = (unsigned)(R * K + C) * 2u; voffB[i] = (unsigned)(Rb * K + C) * 2u; }
    const size_t kstep = (size_t)(BK * 2);
    const size_t hstep = (size_t)HALF * K * 2;
    const size_t tstep = 2 * hstep;
    const unsigned ldsw = (unsigned)wid * 1024u;
    const int aoff = lds_byte(wr * 64 + fr, fq * 8), boff = lds_byte(wc * 32 + fr, fq * 8);
#define PG8_SA(b, h) (((b) * 2 + (h)) * HTB)
#define PG8_SB(b, h) ((4 + (b) * 2 + (h)) * HTB)
#define PG8_STAGE(bufoff, gbase, voff) do { _Pragma("unroll") for (int _i = 0; _i < 2; ++_i) \
        __builtin_amdgcn_global_load_lds((const unsigned*)((const char*)(gbase) + (voff)[_i]), (LAS unsigned*)(lds + (bufoff) + ldsw + _i * 8192), 16, 0, 0); } while (0)
#define PG8_LDA(dst, b, h) do { _Pragma("unroll") for (int m = 0; m < 4; ++m) _Pragma("unroll") for (int k = 0; k < 2; ++k) dst[m][k] = *(const LAS bf16x8*)(lds + PG8_SA(b, h) + aoff + m * 2048 + k * 1024); } while (0)
#define PG8_LDB(dst, b, h) do { _Pragma("unroll") for (int n = 0; n < 2; ++n) _Pragma("unroll") for (int k = 0; k < 2; ++k) dst[n][k] = *(const LAS bf16x8*)(lds + PG8_SB(b, h) + boff + n * 2048 + k * 1024); } while (0)
#define PG8_MMA(ai, bj, At, Bt) do { __builtin_amdgcn_s_setprio(1); _Pragma("unroll") for (int m = 0; m < 4; ++m) _Pragma("unroll") for (int n = 0; n < 2; ++n) _Pragma("unroll") for (int k = 0; k < 2; ++k) \
        acc[ai][bj][m][n] = __builtin_amdgcn_mfma_f32_16x16x32_bf16(Bt[n][k], At[m][k], acc[ai][bj][m][n], 0, 0, 0); __builtin_amdgcn_s_setprio(0); } while (0)
#define PG8_WAIT_V(n) asm volatile("s_waitcnt vmcnt(" #n ")" ::: "memory")
#define PG8_WAIT_L(n) asm volatile("s_waitcnt lgkmcnt(" #n ")" ::: "memory")
#define PG8_BAR __builtin_amdgcn_s_barrier()
#define PG8_SCHED __builtin_amdgcn_sched_barrier(0)
    Unit cur, nxt; int ui = 0;
    if (!S.next(0, cur)) return;
    f32x4 acc[2][2][4][2];
#pragma unroll
    for (int a = 0; a < 2; ++a)
#pragma unroll
        for (int b = 0; b < 2; ++b)
#pragma unroll
            for (int m = 0; m < 4; ++m)
#pragma unroll
                for (int n = 0; n < 2; ++n) acc[a][b][m][n] = (f32x4){0.f, 0.f, 0.f, 0.f};
    bf16x8 At[4][2], B0[2][2], B1[2][2];
    const char* cA = (const char*)g.A + (size_t)cur.pm * tstep; const char* cB = (const char*)g.Bt + (size_t)cur.pn * tstep;
    PG8_STAGE(PG8_SB(0, 0), cB, voffB); PG8_STAGE(PG8_SB(0, 1), cB + hstep, voffB); PG8_STAGE(PG8_SA(0, 0), cA, voffA); PG8_STAGE(PG8_SA(0, 1), cA + hstep, voffA);
    if (wr == 1) PG8_BAR;
    PG8_WAIT_V(2); PG8_BAR;
    PG8_STAGE(PG8_SB(1, 0), cB + kstep, voffB); PG8_STAGE(PG8_SA(1, 0), cA + kstep, voffA); PG8_STAGE(PG8_SB(1, 1), cB + hstep + kstep, voffB);
    PG8_WAIT_V(6); PG8_BAR;
    for (;;) {
        const bool has_next = S.next(ui + 1, nxt);
        const char* nA = has_next ? (const char*)g.A + (size_t)nxt.pm * tstep : cA; const char* nB = has_next ? (const char*)g.Bt + (size_t)nxt.pn * tstep : cB;
        for (int t = 0; t < nt; t += 2) {
            const bool last = (t == nt - 2);
            const char* a1 = cA + (size_t)(t + 1) * kstep;
            const char* a2 = last ? nA : cA + (size_t)(t + 2) * kstep; const char* b2 = last ? nB : cB + (size_t)(t + 2) * kstep;
            const char* a3 = a2 + kstep; const char* b3 = b2 + kstep;
            PG8_LDB(B0, 0, 0); PG8_LDB(B1, 0, 1); PG8_SCHED; PG8_LDA(At, 0, 0); PG8_STAGE(PG8_SA(1, 1), a1 + hstep, voffA);
            PG8_WAIT_V(8); PG8_WAIT_L(0); PG8_BAR; PG8_MMA(0, 0, At, B0); PG8_MMA(0, 1, At, B1); PG8_BAR; PG8_SCHED;
            PG8_LDA(At, 0, 1); PG8_STAGE(PG8_SB(0, 0), b2, voffB); PG8_STAGE(PG8_SB(0, 1), b2 + hstep, voffB); PG8_STAGE(PG8_SA(0, 0), a2, voffA);
            PG8_WAIT_V(8); PG8_WAIT_L(0); PG8_BAR; PG8_MMA(1, 0, At, B0); PG8_MMA(1, 1, At, B1); PG8_BAR; PG8_SCHED;
            PG8_LDB(B0, 1, 0); PG8_LDB(B1, 1, 1); PG8_SCHED; PG8_LDA(At, 1, 0); PG8_STAGE(PG8_SA(0, 1), a2 + hstep, voffA);
            PG8_WAIT_V(8); PG8_WAIT_L(0); PG8_BAR; PG8_MMA(0, 0, At, B0); PG8_MMA(0, 1, At, B1); PG8_BAR; PG8_SCHED;
            PG8_LDA(At, 1, 1); PG8_STAGE(PG8_SB(1, 0), b3, voffB); PG8_STAGE(PG8_SB(1, 1), b3 + hstep, voffB); PG8_STAGE(PG8_SA(1, 0), a3, voffA);
            PG8_WAIT_V(8); PG8_WAIT_L(0); PG8_BAR; PG8_MMA(1, 0, At, B0); PG8_MMA(1, 1, At, B1); PG8_BAR; PG8_SCHED;
        }
        if (wr == 0) PG8_BAR;
        E(acc, cur, ui, wr, wc, fr, fq);
        if (!has_next) break;
        if (!(Epi::PAIRED && (ui & 1) == 0)) {
#pragma unroll
            for (int a = 0; a < 2; ++a)
#pragma unroll
                for (int b = 0; b < 2; ++b)
#pragma unroll
                    for (int m = 0; m < 4; ++m)
#pragma unroll
                        for (int n = 0; n < 2; ++n) acc[a][b][m][n] = (f32x4){0.f, 0.f, 0.f, 0.f};
        }
        cur = nxt; cA = nA; cB = nB; ++ui;
        if (wr == 1) PG8_BAR;
    }
    PG8_WAIT_V(0);
    PG8_BAR;
#undef PG8_SA
#undef PG8_SB
#undef PG8_STAGE
#undef PG8_LDA
#undef PG8_LDB
#undef PG8_MMA
#undef PG8_WAIT_V
#undef PG8_WAIT_L
#undef PG8_BAR
#undef PG8_SCHED
}
}

typedef f32x4 acc_t[2][2][4][2];

struct EpiIn {
    static constexpr bool PERM = true, PAIRED = false;
    unsigned char* ws; bf16_t* Rg; bf16_t* Gg;
    __device__ __forceinline__ void operator()(acc_t& acc, const pg8::Unit& u, int ui, int wr, int wc, int fr, int fq) const {
        const int row0 = u.pm * 256 + wr * 64 + fr; const int pn = u.pn;
        if (pn < 16 || pn == 24) {
            bf16_t* base; int ldc, colt;
            if (pn < 2) { base = (bf16_t*)(ws + Z_Q); ldc = 512; colt = pn * 256; }
            else if (pn < 4) { base = (bf16_t*)(ws + Z_K); ldc = 512; colt = (pn - 2) * 256; }
            else if (pn < 8) { base = (bf16_t*)(ws + Z_V); ldc = 1024; colt = (pn - 4) * 256; }
            else if (pn < 12) { base = (bf16_t*)(ws + Z_G); ldc = 1024; colt = (pn - 8) * 256; }
            else if (pn < 16) { base = (bf16_t*)(ws + Z_CB); ldc = 1024; colt = (pn - 12) * 256; }
            else { base = (bf16_t*)(ws + Z_A); ldc = 256; colt = 0; }
            const int col0 = colt + wc * 32 + 8 * fq;
#pragma unroll
            for (int ai = 0; ai < 2; ++ai)
#pragma unroll
                for (int m = 0; m < 4; ++m) { bf16_t* rowp = base + (size_t)(row0 + ai * 128 + m * 16) * ldc + col0;
#pragma unroll
                    for (int bj = 0; bj < 2; ++bj) { const f32x4 v0 = acc[ai][bj][m][0], v1 = acc[ai][bj][m][1];
                        u32x4 w; w.x = cvt_pk_bf16(v0[0], v0[1]); w.y = cvt_pk_bf16(v0[2], v0[3]); w.z = cvt_pk_bf16(v1[0], v1[1]); w.w = cvt_pk_bf16(v1[2], v1[3]);
                        *(u32x4*)(rowp + bj * 128) = w; } }
        } else if (pn < 24) {
            bf16_t* base = (bf16_t*)(ws + Z_P); const int ch0 = (pn - 16) * 128 + wc * 16 + 4 * fq;
#pragma unroll
            for (int ai = 0; ai < 2; ++ai)
#pragma unroll
                for (int m = 0; m < 4; ++m) { bf16_t* rowp = base + (size_t)(row0 + ai * 128 + m * 16) * 1024 + ch0;
#pragma unroll
                    for (int bj = 0; bj < 2; ++bj) { const f32x4 p = acc[ai][bj][m][0] * acc[ai][bj][m][1];
                        u32x2 w; w.x = cvt_pk_bf16(p[0], p[1]); w.y = cvt_pk_bf16(p[2], p[3]); *(u32x2*)(rowp + bj * 64) = w; } }
        } else {
            const int ch0 = (pn - 25) * 128 + wc * 16 + 4 * fq;
#pragma unroll
            for (int ai = 0; ai < 2; ++ai)
#pragma unroll
                for (int m = 0; m < 4; ++m) { const size_t ro = (size_t)(row0 + ai * 128 + m * 16) * 1024 + ch0;
#pragma unroll
                    for (int bj = 0; bj < 2; ++bj) { const f32x4 ga = acc[ai][bj][m][0], gb = acc[ai][bj][m][1]; float r[4], s[4];
#pragma unroll
                        for (int j = 0; j < 4; ++j) { const float ea = __expf(-ga[j]), eb = __expf(-gb[j]); s[j] = __builtin_amdgcn_rcpf(1.0f + eb); r[j] = (1.0f + eb) * __builtin_amdgcn_rcpf(1.0f + ea); }
                        u32x2 w; w.x = cvt_pk_bf16(r[0], r[1]); w.y = cvt_pk_bf16(r[2], r[3]); *(u32x2*)(Rg + ro + bj * 64) = w;
                        u32x2 x; x.x = cvt_pk_bf16(s[0], s[1]); x.y = cvt_pk_bf16(s[2], s[3]); *(u32x2*)(Gg + ro + bj * 64) = x; } }
        }
    }
};

struct EpiMerge {
    static constexpr bool PERM = true, PAIRED = true;
    const bf16_t* Rg; const bf16_t* Gg; bf16_t* O;
    __device__ __forceinline__ void operator()(acc_t& acc, const pg8::Unit& u, int ui, int wr, int wc, int fr, int fq) const {
        const int second = ui & 1; const int pm = second ? u.pm - 66 : u.pm, pn = second ? u.pn - 4 : u.pn;
        const int row0 = pm * 256 + wr * 64 + fr, col0 = pn * 256 + wc * 32 + 8 * fq;
        const bf16_t* src = second ? Gg : Rg;
#pragma unroll
        for (int ai = 0; ai < 2; ++ai) { u32x4 ff[4][2];
#pragma unroll
            for (int m = 0; m < 4; ++m)
#pragma unroll
                for (int bj = 0; bj < 2; ++bj) ff[m][bj] = *(const u32x4*)(src + (size_t)(row0 + ai * 128 + m * 16) * 1024 + col0 + bj * 128);
#pragma unroll
            for (int m = 0; m < 4; ++m) { const size_t ro = (size_t)(row0 + ai * 128 + m * 16) * 1024 + col0;
#pragma unroll
                for (int bj = 0; bj < 2; ++bj) { const u32x4 f = ff[m][bj];
                    f32x4 v0 = acc[ai][bj][m][0], v1 = acc[ai][bj][m][1];
                    v0[0] *= bf_lo(f.x); v0[1] *= bf_hi(f.x); v0[2] *= bf_lo(f.y); v0[3] *= bf_hi(f.y);
                    v1[0] *= bf_lo(f.z); v1[1] *= bf_hi(f.z); v1[2] *= bf_lo(f.w); v1[3] *= bf_hi(f.w);
                    if (second) { u32x4 w; w.x = cvt_pk_bf16(v0[0], v0[1]); w.y = cvt_pk_bf16(v0[2], v0[3]); w.z = cvt_pk_bf16(v1[0], v1[1]); w.w = cvt_pk_bf16(v1[2], v1[3]);
                        *(u32x4*)(O + ro + bj * 128) = w; }
                    else { acc[ai][bj][m][0] = v0; acc[ai][bj][m][1] = v1; } } } }
    }
};

struct EpiRes {
    static constexpr bool PERM = false, PAIRED = false;
    const float* base0; const float* base1;
    float* out; const float* gate;
    __device__ __forceinline__ void operator()(acc_t& acc, const pg8::Unit& u, int ui, int wr, int wc, int fr, int fq) const {
        const int row0 = u.pm * 256 + wr * 64 + fr, col0 = u.pn * 256 + wc * 32 + 4 * fq;
#pragma unroll
        for (int ai = 0; ai < 2; ++ai)
#pragma unroll
            for (int m = 0; m < 4; ++m) { const int row = row0 + ai * 128 + m * 16;
                const float* bp = (row < MP ? base0 + (size_t)row * 1024 : base1 + (size_t)(row - MP) * 1024) + col0;
                const float* gp = gate + (size_t)modrow_of(row) * NMOD + col0; float* op = out + (size_t)row * 1024 + col0;
#pragma unroll
                for (int bj = 0; bj < 2; ++bj)
#pragma unroll
                    for (int n = 0; n < 2; ++n) { const f32x4 b = *(const f32x4*)(bp + bj * 128 + n * 16), gt = *(const f32x4*)(gp + bj * 128 + n * 16);
                        *(f32x4*)(op + bj * 128 + n * 16) = b + gt * acc[ai][bj][m][n]; }
                asm volatile("" ::: "memory"); }
    }
};

struct EpiResNorm {
    static constexpr bool PERM = false, PAIRED = false;
    const float* base; float* out; const float* gate; const float* gamma; float* rowss; unsigned* cnt;
    __device__ __forceinline__ void operator()(acc_t& acc, const pg8::Unit& u, int ui, int wr, int wc, int fr, int fq) const {
        const int row0 = u.pm * 256 + wr * 64 + fr, col0 = u.pn * 256 + wc * 32 + 4 * fq;
        const float* gp = gate + (size_t)modrow_of(u.pm * 256) * NMOD + col0;
        f32x4 gt[2][2];
#pragma unroll
        for (int bj = 0; bj < 2; ++bj)
#pragma unroll
            for (int n = 0; n < 2; ++n) gt[bj][n] = *(const f32x4*)(gp + bj * 128 + n * 16);
#pragma unroll
        for (int ai = 0; ai < 2; ++ai)
#pragma unroll
            for (int m = 0; m < 4; ++m) { const int row = row0 + ai * 128 + m * 16; const float* bp = base + (size_t)row * 1024 + col0; float ss = 0.f;
#pragma unroll
                for (int bj = 0; bj < 2; ++bj)
#pragma unroll
                    for (int n = 0; n < 2; ++n) { const f32x4 b = *(const f32x4*)(bp + bj * 128 + n * 16); const f32x4 o = b + gt[bj][n] * acc[ai][bj][m][n]; acc[ai][bj][m][n] = o;
                        ss += o[0] * o[0] + o[1] * o[1] + o[2] * o[2] + o[3] * o[3]; }
                ss += __shfl_xor(ss, 16); ss += __shfl_xor(ss, 32);
                if (fq == 0) (void)__hip_atomic_fetch_add(rowss + row, ss, __ATOMIC_RELAXED, __HIP_MEMORY_SCOPE_AGENT);
                asm volatile("" ::: "memory"); }
        asm volatile("s_waitcnt vmcnt(0)" ::: "memory");
        __syncthreads();
        if (threadIdx.x == 0) { (void)__hip_atomic_fetch_add(cnt + 64 * u.pm, 1u, __ATOMIC_RELAXED, __HIP_MEMORY_SCOPE_AGENT);
            unsigned sp = 0u; while (__hip_atomic_load(cnt + 64 * u.pm, __ATOMIC_RELAXED, __HIP_MEMORY_SCOPE_AGENT) < 4u) { __builtin_amdgcn_s_sleep(2); if (++sp > (1u << 22)) break; } }
        __syncthreads();
        float rs[8];
#pragma unroll
        for (int gi = 0; gi < 8; ++gi) rs[gi] = __hip_atomic_load(rowss + row0 + (gi >> 2) * 128 + (gi & 3) * 16, __ATOMIC_RELAXED, __HIP_MEMORY_SCOPE_AGENT);
        f32x4 gm[2][2];
#pragma unroll
        for (int bj = 0; bj < 2; ++bj)
#pragma unroll
            for (int n = 0; n < 2; ++n) gm[bj][n] = *(const f32x4*)(gamma + col0 + bj * 128 + n * 16);
#pragma unroll
        for (int ai = 0; ai < 2; ++ai)
#pragma unroll
            for (int m = 0; m < 4; ++m) { const float r_ = rsqrtf(rs[ai * 4 + m] * (1.0f / 1024.0f) + EPS); float* op = out + (size_t)(row0 + ai * 128 + m * 16) * 1024 + col0;
#pragma unroll
                for (int bj = 0; bj < 2; ++bj)
#pragma unroll
                    for (int n = 0; n < 2; ++n) *(f32x4*)(op + bj * 128 + n * 16) = acc[ai][bj][m][n] * r_ * gm[bj][n]; }
    }
};

struct EpiResNormMod {
    static constexpr bool PERM = false, PAIRED = false;
    const float* base; float* out; bf16_t* H; const float* mod; const float* g2n; float* rowss; unsigned* cnt;
    __device__ __forceinline__ void operator()(acc_t& acc, const pg8::Unit& u, int ui, int wr, int wc, int fr, int fq) const {
        const int row0 = u.pm * 256 + wr * 64 + fr, col0 = u.pn * 256 + wc * 32 + 4 * fq;
        const float* mp = mod + (size_t)modrow_of(u.pm * 256) * NMOD + col0;
        { f32x4 gt[2][2];
#pragma unroll
          for (int bj = 0; bj < 2; ++bj)
#pragma unroll
              for (int n = 0; n < 2; ++n) gt[bj][n] = *(const f32x4*)(mp + 2048 + bj * 128 + n * 16);
#pragma unroll
          for (int ai = 0; ai < 2; ++ai)
#pragma unroll
              for (int m = 0; m < 4; ++m) { const int row = row0 + ai * 128 + m * 16; const size_t oo = (size_t)row * 1024 + col0; float ss = 0.f;
#pragma unroll
                  for (int bj = 0; bj < 2; ++bj)
#pragma unroll
                      for (int n = 0; n < 2; ++n) { const f32x4 b = *(const f32x4*)(base + oo + bj * 128 + n * 16); const f32x4 o = b + gt[bj][n] * acc[ai][bj][m][n]; acc[ai][bj][m][n] = o;
                          *(f32x4*)(out + oo + bj * 128 + n * 16) = o; ss += o[0] * o[0] + o[1] * o[1] + o[2] * o[2] + o[3] * o[3]; }
                  ss += __shfl_xor(ss, 16); ss += __shfl_xor(ss, 32);
                  if (fq == 0) (void)__hip_atomic_fetch_add(rowss + row, ss, __ATOMIC_RELAXED, __HIP_MEMORY_SCOPE_AGENT);
                  asm volatile("" ::: "memory"); } }
        asm volatile("s_waitcnt vmcnt(0)" ::: "memory");
        __syncthreads();
        if (threadIdx.x == 0) { (void)__hip_atomic_fetch_add(cnt + 64 * u.pm, 1u, __ATOMIC_RELAXED, __HIP_MEMORY_SCOPE_AGENT);
            unsigned sp = 0u; while (__hip_atomic_load(cnt + 64 * u.pm, __ATOMIC_RELAXED, __HIP_MEMORY_SCOPE_AGENT) < 4u) { __builtin_amdgcn_s_sleep(2); if (++sp > (1u << 22)) break; } }
        __syncthreads();
        float rs[8];
#pragma unroll
        for (int gi = 0; gi < 8; ++gi) rs[gi] = __hip_atomic_load(rowss + row0 + (gi >> 2) * 128 + (gi & 3) * 16, __ATOMIC_RELAXED, __HIP_MEMORY_SCOPE_AGENT);
        f32x4 fs[2][2], sh[2][2];
#pragma unroll
        for (int bj = 0; bj < 2; ++bj)
#pragma unroll
            for (int n = 0; n < 2; ++n) { const f32x4 sc = *(const f32x4*)(mp + 4096 + bj * 128 + n * 16), gm = *(const f32x4*)(g2n + col0 + bj * 128 + n * 16);
                fs[bj][n] = gm * (sc + 1.0f); sh[bj][n] = *(const f32x4*)(mp + 3072 + bj * 128 + n * 16); }
#pragma unroll
        for (int ai = 0; ai < 2; ++ai)
#pragma unroll
            for (int m = 0; m < 4; ++m) { const float r_ = rsqrtf(rs[ai * 4 + m] * (1.0f / 1024.0f) + EPS); bf16_t* hp = H + (size_t)(row0 + ai * 128 + m * 16) * 1024 + col0;
#pragma unroll
                for (int bj = 0; bj < 2; ++bj)
#pragma unroll
                    for (int n = 0; n < 2; ++n) { const f32x4 h = acc[ai][bj][m][n] * r_ * fs[bj][n] + sh[bj][n];
                        *(u32x2*)(hp + bj * 128 + n * 16) = (u32x2){cvt_pk_bf16(h[0], h[1]), cvt_pk_bf16(h[2], h[3])}; } }
    }
};

struct EpiAct {
    static constexpr bool PERM = true, PAIRED = false;
    bf16_t* O;
    __device__ __forceinline__ void operator()(acc_t& acc, const pg8::Unit& u, int ui, int wr, int wc, int fr, int fq) const {
        const int row0 = u.pm * 256 + wr * 64 + fr, ch0 = u.pn * 128 + wc * 32 + 8 * fq;
#pragma unroll
        for (int ai = 0; ai < 2; ++ai)
#pragma unroll
            for (int m = 0; m < 4; ++m) { bf16_t* rowp = O + (size_t)(row0 + ai * 128 + m * 16) * DFF + ch0; unsigned w[4];
#pragma unroll
                for (int bj = 0; bj < 2; ++bj) { const f32x4 gt = acc[ai][bj][m][0], up = acc[ai][bj][m][1]; float a[4];
#pragma unroll
                    for (int j = 0; j < 4; ++j) a[j] = gt[j] * up[j] * __builtin_amdgcn_rcpf(1.0f + __expf(-gt[j]));
                    w[2 * bj] = cvt_pk_bf16(a[0], a[1]); w[2 * bj + 1] = cvt_pk_bf16(a[2], a[3]); }
                *(u32x4*)rowp = (u32x4){w[0], w[1], w[2], w[3]}; }
    }
};

__device__ __forceinline__ int pairrow(int idx, int n) { const int tp = idx >> 7, w = idx & 127; return 256 * tp + 32 * (w >> 4) + 8 * ((w >> 2) & 3) + 4 * n + (w & 3); }
__device__ __forceinline__ int map_win(int c) {
    if (c < 3072) return c;
    if (c < 3088) return 6144 + (c - 3072);
    if (c < 4112) return 3072 + (c - 3088);
    if (c < 5136) return 4096 + pairrow(c - 4112, 0);
    if (c < 6160) return 4096 + pairrow(c - 5136, 1);
    if (c < 7184) return 6400 + pairrow(c - 6160, 0);
    return 6400 + pairrow(c - 7184, 1);
}
__device__ __forceinline__ int act_perm(int k) { return (k & ~127) + 32 * ((k >> 4) & 3) + 8 * ((k >> 2) & 3) + 4 * ((k >> 6) & 1) + (k & 3); }
__device__ __forceinline__ void xpose_wave4(const float* src, int Nsrc, int k0, int c0, bf16_t* dst, int dpitch, int mapid, int lane) {
    const int c = c0 + 4 * lane; if (c >= Nsrc) return;
    const float* sp = src + (size_t)k0 * Nsrc + c;
    f32x4 v[32];
#pragma unroll
    for (int j = 0; j < 32; ++j) v[j] = *(const f32x4*)(sp + (size_t)j * Nsrc);
#pragma unroll
    for (int q = 0; q < 4; ++q) { const int cc = c + q; int R = cc; if (mapid == 1) R = map_win(cc); else if (mapid == 2) R = cc < DFF ? pairrow(cc, 0) : pairrow(cc - DFF, 1);
        bf16_t* dp = dst + (size_t)R * dpitch + k0;
#pragma unroll
        for (int kg = 0; kg < 4; ++kg) { u32x4 w; w.x = cvt_pk_bf16(v[kg * 8 + 0][q], v[kg * 8 + 1][q]); w.y = cvt_pk_bf16(v[kg * 8 + 2][q], v[kg * 8 + 3][q]);
            w.z = cvt_pk_bf16(v[kg * 8 + 4][q], v[kg * 8 + 5][q]); w.w = cvt_pk_bf16(v[kg * 8 + 6][q], v[kg * 8 + 7][q]);
            if (mapid == 3) { bf16_t* d0 = dst + (size_t)R * dpitch;
                *(u32x2*)(d0 + act_perm(k0 + kg * 8)) = (u32x2){w.x, w.y}; *(u32x2*)(d0 + act_perm(k0 + kg * 8 + 4)) = (u32x2){w.z, w.w}; }
            else *(u32x4*)(dp + kg * 8) = w; } }
}
__device__ __forceinline__ void xpose_task(const Params& P, int task, int lane) {
    unsigned char* ws = P.ws;
    if (task < 1056) { xpose_wave4(P.in[9], 8208, (task / 33) * 32, (task % 33) * 256, (bf16_t*)(ws + WS_WIN), 1024, 1, lane); }
    else if (task < 1184) { const int t = task - 1056; xpose_wave4(P.in[13], 1024, (t >> 2) * 32, (t & 3) * 256, (bf16_t*)(ws + WS_WGC), 1024, 0, lane); }
    else if (task < 1312) { const int t = task - 1184; xpose_wave4(P.in[16], 1024, (t >> 2) * 32, (t & 3) * 256, (bf16_t*)(ws + WS_WGC) + (size_t)1024 * 1024, 1024, 0, lane); }
    else if (task < 1440) { const int t = task - 1312; xpose_wave4(P.in[17], 1024, (t >> 2) * 32, (t & 3) * 256, (bf16_t*)(ws + WS_WO), 1024, 0, lane); }
    else if (task < 2144) { const int t = task - 1440; xpose_wave4(P.in[19], 5632, (t / 22) * 32, (t % 22) * 256, (bf16_t*)(ws + WS_WF1), 1024, 2, lane); }
    else { const int t = task - 2144; xpose_wave4(P.in[20], 1024, (t >> 2) * 32, (t & 3) * 256, (bf16_t*)(ws + WS_WF2), DFF, 3, lane); }
}
__device__ void phase0(const Params& P, LAS unsigned char* lds) {
    const int tid = opaque_tid(), G = gridDim.x;
    unsigned char* ws = P.ws;
    { u32x4* z = (u32x4*)(ws + WS_WIN + (size_t)6160 * 2048); const int n16 = 240 * 2048 / 16;
      for (int i = blockIdx.x * 512 + tid; i < n16; i += G * 512) z[i] = (u32x4){0u, 0u, 0u, 0u}; }
    { const int lane = tid & 63, wid = tid >> 6;
      for (int task = blockIdx.x * 8 + wid; task < 2496; task += G * 8) xpose_task(P, task, lane); }
    for (int task2 = (int)G - 1 - (int)blockIdx.x; task2 < 192; task2 += G) {
        const int task = task2 >> 1, kh = task2 & 1;
        const int lane = tid & 63, wid = __builtin_amdgcn_readfirstlane(tid >> 6), n0 = task * 64;
        LAS float* CL = (LAS float*)lds; LAS float* RED = (LAS float*)(lds + 81920);
#pragma unroll
        for (int i = 0; i < 2; ++i) { const int idx = (tid + i * 512) * 4; *(LAS f32x4*)(CL + idx) = *(const f32x4*)(P.in[2] + idx); }
#pragma unroll
        for (int i = 0; i < 8; ++i) { const int idx = (tid + i * 512) * 4; *(LAS f32x4*)(CL + 4096 + idx) = *(const f32x4*)(P.in[3] + idx); }
        __syncthreads();
        float a[20];
#pragma unroll
        for (int r = 0; r < 20; ++r) a[r] = 0.f;
        const int kb = kh * 512 + wid * 64;
        const float* wp = P.in[6] + (size_t)kb * NMOD + n0 + lane;
#pragma unroll 4
        for (int k8 = 0; k8 < 64; k8 += 8) { float wv[8];
#pragma unroll
            for (int j = 0; j < 8; ++j) wv[j] = wp[(size_t)(k8 + j) * NMOD];
#pragma unroll
            for (int r = 0; r < 20; ++r) { const f32x4 c0 = *(const LAS f32x4*)(CL + r * 1024 + kb + k8), c1 = *(const LAS f32x4*)(CL + r * 1024 + kb + k8 + 4);
                a[r] += c0[0] * wv[0] + c0[1] * wv[1] + c0[2] * wv[2] + c0[3] * wv[3] + c1[0] * wv[4] + c1[1] * wv[5] + c1[2] * wv[6] + c1[3] * wv[7]; } }
#pragma unroll
        for (int r = 0; r < 20; ++r) RED[(wid * 20 + r) * 64 + lane] = a[r];
        __syncthreads();
        for (int o = tid; o < 1280; o += 512) { const int r = o >> 6, cc = o & 63; float sum = kh ? 0.f : P.in[7][n0 + cc];
#pragma unroll
            for (int q = 0; q < 8; ++q) sum += RED[(q * 20 + r) * 64 + cc];
            atomicAdd((float*)(ws + WS_MOD) + r * NMOD + n0 + cc, sum); }
        __syncthreads();
    }
}

__device__ void phase_norm_mod(const float* x0, const float* x1, const float* gamma, const float* mod, int sh_off, int sc_off, bf16_t* H) {
    const int tid_ = opaque_tid(), lane = tid_ & 63, wid = tid_ >> 6; const int stride = gridDim.x * 8;
    for (int rowa = blockIdx.x * 8 + wid; rowa < MTOT; rowa += 2 * stride) {
        const int rowb = rowa + stride; const bool hasb = rowb < MTOT; const int rb = hasb ? rowb : rowa;
        const float* xa = rowa < MP ? x0 + (size_t)rowa * 1024 : x1 + (size_t)(rowa - MP) * 1024;
        const float* xb = rb < MP ? x0 + (size_t)rb * 1024 : x1 + (size_t)(rb - MP) * 1024;
        f32x4 v[2][4];
#pragma unroll
        for (int i = 0; i < 2; ++i) { v[0][2 * i] = *(const f32x4*)(xa + i * 512 + lane * 8); v[0][2 * i + 1] = *(const f32x4*)(xa + i * 512 + lane * 8 + 4);
                                      v[1][2 * i] = *(const f32x4*)(xb + i * 512 + lane * 8); v[1][2 * i + 1] = *(const f32x4*)(xb + i * 512 + lane * 8 + 4); }
#pragma unroll
        for (int q = 0; q < 2; ++q) { const int row = q ? rb : rowa; if (q && !hasb) break;
            float ss = 0.f;
#pragma unroll
            for (int i = 0; i < 4; ++i) ss += v[q][i][0] * v[q][i][0] + v[q][i][1] * v[q][i][1] + v[q][i][2] * v[q][i][2] + v[q][i][3] * v[q][i][3];
#pragma unroll
            for (int o = 32; o >= 1; o >>= 1) ss += __shfl_xor(ss, o);
            const float rstd = rsqrtf(ss * (1.0f / 1024.0f) + EPS);
            const float* mp = mod + (size_t)modrow_of(row) * NMOD;
#pragma unroll
            for (int i = 0; i < 2; ++i) { const int c = i * 512 + lane * 8; float o[8];
#pragma unroll
                for (int hlf = 0; hlf < 2; ++hlf) { const f32x4 g = *(const f32x4*)(gamma + c + 4 * hlf), sc = *(const f32x4*)(mp + sc_off + c + 4 * hlf), sh = *(const f32x4*)(mp + sh_off + c + 4 * hlf);
#pragma unroll
                    for (int j = 0; j < 4; ++j) o[4 * hlf + j] = v[q][2 * i + hlf][j] * rstd * g[j] * (1.0f + sc[j]) + sh[j]; }
                u32x4 w; w.x = cvt_pk_bf16(o[0], o[1]); w.y = cvt_pk_bf16(o[2], o[3]); w.z = cvt_pk_bf16(o[4], o[5]); w.w = cvt_pk_bf16(o[6], o[7]);
                *(u32x4*)(H + (size_t)row * 1024 + c) = w; } }
    }
}
__device__ void phase_final_norm(float* x, const float* gamma) {
    const int tid_ = opaque_tid(), lane = tid_ & 63, wid = tid_ >> 6; const int stride = gridDim.x * 8;
    f32x4 g[4];
#pragma unroll
    for (int i = 0; i < 4; ++i) g[i] = *(const f32x4*)(gamma + i * 256 + lane * 4);
    for (int rowa = blockIdx.x * 8 + wid; rowa < MTOT; rowa += 2 * stride) {
        const int rowb = rowa + stride; const bool hasb = rowb < MTOT;
        float* xa = x + (size_t)rowa * 1024; float* xb = x + (size_t)(hasb ? rowb : rowa) * 1024; f32x4 v[2][4];
#pragma unroll
        for (int i = 0; i < 4; ++i) { v[0][i] = *(const f32x4*)(xa + i * 256 + lane * 4); v[1][i] = *(const f32x4*)(xb + i * 256 + lane * 4); }
#pragma unroll
        for (int q = 0; q < 2; ++q) { if (q && !hasb) break; float* xp = q ? xb : xa; float ss = 0.f;
#pragma unroll
            for (int i = 0; i < 4; ++i) ss += v[q][i][0] * v[q][i][0] + v[q][i][1] * v[q][i][1] + v[q][i][2] * v[q][i][2] + v[q][i][3] * v[q][i][3];
#pragma unroll
            for (int o = 32; o >= 1; o >>= 1) ss += __shfl_xor(ss, o);
            const float rstd = rsqrtf(ss * (1.0f / 1024.0f) + EPS);
#pragma unroll
            for (int i = 0; i < 4; ++i) *(f32x4*)(xp + i * 256 + lane * 4) = v[q][i] * rstd * g[i]; }
    }
}

__device__ void conv_block(const Params& P, int blk) {
    const int tid = opaque_tid(), cgp = tid & 127, rg = tid >> 7, c0 = cgp * 8;
    const int row0 = blk * 64 + rg * 16;
    const bf16_t* zp = (const bf16_t*)(P.ws + Z_P); bf16_t* zcb = (bf16_t*)(P.ws + Z_CB);
    int seq0, seqlen; float* cache_out;
    if (row0 < MP) { seq0 = row0 & ~4095; seqlen = 4096; cache_out = P.out + O_CP + (size_t)(row0 >> 12) * 2048; }
    else { const int sb = (row0 - MP) >> 5; seq0 = MP + sb * 32; seqlen = 32; cache_out = P.out + O_CS + (size_t)sb * 2048; }
    float w0[8], w1[8], w2[8], bs[8], p1[8], p2[8];
#pragma unroll
    for (int j = 0; j < 8; ++j) { w0[j] = P.in[14][c0 + j]; w1[j] = P.in[14][1024 + c0 + j]; w2[j] = P.in[14][2048 + c0 + j]; bs[j] = P.in[15][c0 + j]; }
    if (row0 == seq0) {
        if (row0 < MP) {
#pragma unroll
            for (int j = 0; j < 8; ++j) { p1[j] = 0.f; p2[j] = 0.f; }
        } else { const float* cp = P.in[5] + (size_t)((row0 - MP) >> 5) * 2048 + c0;
#pragma unroll
            for (int j = 0; j < 8; ++j) { p2[j] = cp[j]; p1[j] = cp[1024 + j]; } }
    } else {
        const u32x4 a = *(const u32x4*)(zp + (size_t)(row0 - 1) * 1024 + c0), b = *(const u32x4*)(zp + (size_t)(row0 - 2) * 1024 + c0);
        p1[0] = bf_lo(a.x); p1[1] = bf_hi(a.x); p1[2] = bf_lo(a.y); p1[3] = bf_hi(a.y); p1[4] = bf_lo(a.z); p1[5] = bf_hi(a.z); p1[6] = bf_lo(a.w); p1[7] = bf_hi(a.w);
        p2[0] = bf_lo(b.x); p2[1] = bf_hi(b.x); p2[2] = bf_lo(b.y); p2[3] = bf_hi(b.y); p2[4] = bf_lo(b.z); p2[5] = bf_hi(b.z); p2[6] = bf_lo(b.w); p2[7] = bf_hi(b.w);
    }
#pragma unroll 1
    for (int i0 = 0; i0 < 16; i0 += 8) {
        u32x4 av[8], bv[8];
#pragma unroll
        for (int i = 0; i < 8; ++i) { av[i] = *(const u32x4*)(zp + (size_t)(row0 + i0 + i) * 1024 + c0); bv[i] = *(const u32x4*)(zcb + (size_t)(row0 + i0 + i) * 1024 + c0); }
#pragma unroll
        for (int i = 0; i < 8; ++i) { const int r = row0 + i0 + i; const u32x4 a = av[i], b = bv[i];
            float p0[8], cb[8], u[8];
            p0[0] = bf_lo(a.x); p0[1] = bf_hi(a.x); p0[2] = bf_lo(a.y); p0[3] = bf_hi(a.y); p0[4] = bf_lo(a.z); p0[5] = bf_hi(a.z); p0[6] = bf_lo(a.w); p0[7] = bf_hi(a.w);
            cb[0] = bf_lo(b.x); cb[1] = bf_hi(b.x); cb[2] = bf_lo(b.y); cb[3] = bf_hi(b.y); cb[4] = bf_lo(b.z); cb[5] = bf_hi(b.z); cb[6] = bf_lo(b.w); cb[7] = bf_hi(b.w);
#pragma unroll
            for (int j = 0; j < 8; ++j) u[j] = cb[j] * (p2[j] * w0[j] + p1[j] * w1[j] + p0[j] * w2[j] + bs[j]);
            u32x4 w; w.x = cvt_pk_bf16(u[0], u[1]); w.y = cvt_pk_bf16(u[2], u[3]); w.z = cvt_pk_bf16(u[4], u[5]); w.w = cvt_pk_bf16(u[6], u[7]);
            *(u32x4*)(zcb + (size_t)r * 1024 + c0) = w;
            const int pos = r - seq0;
            if (pos >= seqlen - 2) { float* co = cache_out + (size_t)(pos - (seqlen - 2)) * 1024 + c0;
                *(f32x4*)co = (f32x4){p0[0], p0[1], p0[2], p0[3]}; *(f32x4*)(co + 4) = (f32x4){p0[4], p0[5], p0[6], p0[7]}; }
#pragma unroll
            for (int j = 0; j < 8; ++j) { p2[j] = p1[j]; p1[j] = p0[j]; }
        }
    }
}

constexpr int L_QE = 0, L_KE = 17408, L_KLT = 34816, L_VT = 53248, L_SC = 90112, L_AL = 99328, L_PSUM = 103424, L_EDEC = 105472, L_PART = 105984, L_LA = 108032, L_GN = 140800;
#define MFMA32(a, b, c) __builtin_amdgcn_mfma_f32_32x32x16_bf16(a, b, c, 0, 0, 0)

#define LBAR() do { asm volatile("s_waitcnt lgkmcnt(0)" ::: "memory"); __builtin_amdgcn_s_barrier(); asm volatile("" ::: "memory"); } while (0)
template <bool OUT>
__device__ void gla_walk(const Params& P, LAS unsigned char* lds, int h, int tok0, int nchunks, int nvalid, const float* Sinit, float* Sfinal, float* Dout) {
    const int tid = opaque_tid(), lane = tid & 63, w = __builtin_amdgcn_readfirstlane(tid >> 6), r = lane & 31, hh = lane >> 5;
    const int d = tid & 127, tq = tid >> 7;
    const bf16_t* zq = (const bf16_t*)(P.ws + Z_Q); const bf16_t* zk = (const bf16_t*)(P.ws + Z_K); const bf16_t* zv = (const bf16_t*)(P.ws + Z_V);
    bf16_t* zg = (bf16_t*)(P.ws + Z_G); const bf16_t* za = (const bf16_t*)(P.ws + Z_A);
    LAS bf16_t* QE = (LAS bf16_t*)(lds + L_QE); LAS bf16_t* KE = (LAS bf16_t*)(lds + L_KE); LAS bf16_t* KLT = (LAS bf16_t*)(lds + L_KLT);
    LAS bf16_t* VT = (LAS bf16_t*)(lds + L_VT); LAS bf16_t* SC = (LAS bf16_t*)(lds + L_SC);
    LAS float* AL = (LAS float*)(lds + L_AL); LAS float* PSUM = (LAS float*)(lds + L_PSUM); LAS float* EDEC = (LAS float*)(lds + L_EDEC); LAS float* PART = (LAS float*)(lds + L_PART); LAS float* LA = (LAS float*)(lds + L_LA); LAS float* GN = (LAS float*)(lds + L_GN);

    f32x16 S[4];
#pragma unroll
    for (int db = 0; db < 4; ++db)
#pragma unroll
        for (int g = 0; g < 16; ++g) S[db][g] = 0.f;
    if (Sinit) { const float* sp = Sinit + (size_t)(4 * hh) * 256 + 32 * w + r;
#pragma unroll
        for (int db = 0; db < 4; ++db)
#pragma unroll
            for (int q4 = 0; q4 < 4; ++q4) { const float* p = sp + (size_t)(32 * db + 8 * q4) * 256; asm volatile("" : "+v"(p));
                S[db][4 * q4 + 0] = p[0]; S[db][4 * q4 + 1] = p[256]; S[db][4 * q4 + 2] = p[512]; S[db][4 * q4 + 3] = p[768]; } }
    const int tb = w >> 2, dbx = w & 3; const bool okb = 32 * tb < nvalid;
    bf16x8 wB; { u32x4 t_; const float* wp_ = P.in[10] + (size_t)(8 * hh) * 512 + h * 128 + 32 * dbx + r;
        t_.x = cvt_pk_bf16(wp_[0], wp_[512]); t_.y = cvt_pk_bf16(wp_[1024], wp_[1536]); t_.z = cvt_pk_bf16(wp_[2048], wp_[2560]); t_.w = cvt_pk_bf16(wp_[3072], wp_[3584]); wB = __builtin_bit_cast(bf16x8, t_); }
    const float balx = P.in[11][h * 128 + 32 * dbx + r];
    if (OUT && tid < 256) GN[tid] = P.in[12][tid];
    float dsum = 0.f;

#ifndef PROBE_G
#define PROBE_G 0
#endif
    volatile LAS unsigned* gts = (volatile LAS unsigned*)(lds + LDS_BYTES - 128 + 56);
    u32x4 av; unsigned vv[16]; unsigned short kr[16], qr[16]; const bool okq = 16 * tq < nvalid;
#define GLA_LOAD(TB) do { \
        av = *(const u32x4*)(za + (size_t)((TB) + (okb ? 32 * tb + r : 0)) * 256 + 8 * hh); \
        { const bf16_t* vb = zv + (size_t)(TB) * 1024 + h * 256; \
          const unsigned vo = (16u * (okq ? (unsigned)tq : 0u)) * 1024u + 2u * (unsigned)d; \
          _Pragma("unroll") \
          for (int tt = 0; tt < 16; ++tt) { const bf16_t* vbt = vb + tt * 1024; const unsigned vraw = *(const unsigned*)(vbt + vo); vv[tt] = okq ? vraw : 0u; } } } while (0)
#define GLA_LOADK(TB) do { \
        { const bf16_t* kb = zk + (size_t)(TB) * 512 + h * 128; \
          const unsigned ko = (16u * (okq ? (unsigned)tq : 0u)) * 512u + (unsigned)d; \
          _Pragma("unroll") \
          for (int tt = 0; tt < 16; ++tt) { const bf16_t* kbt = kb + tt * 512; const unsigned short kraw = kbt[ko]; kr[tt] = okq ? kraw : (unsigned short)0; } } } while (0)
    GLA_LOAD(tok0);
#pragma unroll 1
    for (int ck = 0; ck < nchunks; ++ck, tok0 += 64) {
        unsigned g_t0 = 0; if (PROBE_G && OUT && nvalid == 64 && blockIdx.x == 0 && tid == 0) g_t0 = (unsigned)__builtin_amdgcn_s_memrealtime();
        GLA_LOADK(tok0);
        { u32x4 e0, e1, o0, o1;
          e0.x = (vv[0] & 0xffffu) | (vv[1] << 16); e0.y = (vv[2] & 0xffffu) | (vv[3] << 16); e0.z = (vv[4] & 0xffffu) | (vv[5] << 16); e0.w = (vv[6] & 0xffffu) | (vv[7] << 16);
          e1.x = (vv[8] & 0xffffu) | (vv[9] << 16); e1.y = (vv[10] & 0xffffu) | (vv[11] << 16); e1.z = (vv[12] & 0xffffu) | (vv[13] << 16); e1.w = (vv[14] & 0xffffu) | (vv[15] << 16);
          o0.x = (vv[0] >> 16) | (vv[1] & 0xffff0000u); o0.y = (vv[2] >> 16) | (vv[3] & 0xffff0000u); o0.z = (vv[4] >> 16) | (vv[5] & 0xffff0000u); o0.w = (vv[6] >> 16) | (vv[7] & 0xffff0000u);
          o1.x = (vv[8] >> 16) | (vv[9] & 0xffff0000u); o1.y = (vv[10] >> 16) | (vv[11] & 0xffff0000u); o1.z = (vv[12] >> 16) | (vv[13] & 0xffff0000u); o1.w = (vv[14] >> 16) | (vv[15] & 0xffff0000u);
          *(LAS u32x4*)(VT + (2 * d) * 72 + 16 * tq) = e0; *(LAS u32x4*)(VT + (2 * d) * 72 + 16 * tq + 8) = e1;
          *(LAS u32x4*)(VT + (2 * d + 1) * 72 + 16 * tq) = o0; *(LAS u32x4*)(VT + (2 * d + 1) * 72 + 16 * tq + 8) = o1; }
        if (OUT) { const bf16_t* qb = zq + (size_t)tok0 * 512 + h * 128; const unsigned qo = (16u * (okq ? (unsigned)tq : 0u)) * 512u + (unsigned)d;
#pragma unroll
            for (int tt = 0; tt < 16; ++tt) { const bf16_t* qbt = qb + tt * 512; const unsigned short qraw = qbt[qo]; qr[tt] = okq ? qraw : (unsigned short)0; } }
        { f32x16 xa;
#pragma unroll
          for (int g = 0; g < 16; ++g) xa[g] = balx;
          xa = MFMA32(__builtin_bit_cast(bf16x8, av), wB, xa);
          float T[4], To[4];
#pragma unroll
          for (int q4 = 0; q4 < 4; ++q4) { float run = 0.f;
#pragma unroll
              for (int e = 0; e < 4; ++e) { const float x = xa[4 * q4 + e];
                  float la = (fminf(x, 0.f) - __logf(1.0f + __expf(-fabsf(x)))) * (1.0f / 16.0f);
                  if (!okb) la = 0.f;
                  run += la; xa[4 * q4 + e] = run; }
              T[q4] = run; }
#pragma unroll
          for (int q4 = 0; q4 < 4; ++q4) To[q4] = __shfl_xor(T[q4], 32);
          float base = 0.f;
#pragma unroll
          for (int q4 = 0; q4 < 4; ++q4) { const float mine = base + (hh ? To[q4] : 0.f);
#pragma unroll
              for (int e = 0; e < 4; ++e) LA[(32 * tb + 8 * q4 + 4 * hh + e) * 128 + 32 * dbx + r] = xa[4 * q4 + e] + mine;
              base += T[q4] + To[q4]; }
          if (hh == 0) PSUM[tb * 128 + 32 * dbx + r] = base; }
        LBAR();
        const float ps0 = PSUM[d], ps1 = PSUM[128 + d];
        const float off = (tq >> 1) ? ps0 : 0.f, blast = ps0 + ps1;
        if (tq == 0) { EDEC[d] = __expf(blast); dsum += blast; }
#pragma unroll
        for (int t4 = 0; t4 < 16; t4 += 4) { float kk[4], bb[4];
#pragma unroll
            for (int j = 0; j < 4; ++j) { kk[j] = bf2f(kr[t4 + j]); bb[j] = off + LA[(16 * tq + t4 + j) * 128 + d]; }
            *(LAS u32x2*)(KLT + d * 72 + 16 * tq + t4) = (u32x2){cvt_pk_bf16(kk[0] * __expf(blast - bb[0]), kk[1] * __expf(blast - bb[1])), cvt_pk_bf16(kk[2] * __expf(blast - bb[2]), kk[3] * __expf(blast - bb[3]))};
            if (OUT) {
#pragma unroll
                for (int j = 0; j < 4; ++j) { const int t = 16 * tq + t4 + j;
                    QE[t * 136 + d] = f2bf(bf2f(qr[t4 + j]) * 0.08838834764831845f * __expf(bb[j])); KE[t * 136 + d] = f2bf(kk[j] * __expf(-bb[j])); } } }
        LBAR();
        unsigned g_t1 = 0; if (PROBE_G && OUT && nvalid == 64 && blockIdx.x == 0 && tid == 0) { g_t1 = (unsigned)__builtin_amdgcn_s_memrealtime(); gts[0] += g_t1 - g_t0; }
        if (!OUT) { const int tnext = (ck + 1 < nchunks) ? tok0 + 64 : tok0; GLA_LOAD(tnext); }
        if (OUT) {
            if (w < 3) { const int jb = (w == 2) ? 1 : 0, ib = (w == 0) ? 0 : 1;
                f32x16 a = {0.f, 0.f, 0.f, 0.f, 0.f, 0.f, 0.f, 0.f, 0.f, 0.f, 0.f, 0.f, 0.f, 0.f, 0.f, 0.f};
#pragma unroll
                for (int ks = 0; ks < 8; ++ks) { const bf16x8 A = *(const LAS bf16x8*)(KE + (32 * jb + r) * 136 + 16 * ks + 8 * hh), B = *(const LAS bf16x8*)(QE + (32 * ib + r) * 136 + 16 * ks + 8 * hh);
                    a = MFMA32(A, B, a); }
                const int i = 32 * ib + r;
#pragma unroll
                for (int g = 0; g < 4; ++g) { const int j0 = 32 * jb + 8 * g + 4 * hh; float e[4];
#pragma unroll
                    for (int q = 0; q < 4; ++q) e[q] = (j0 + q <= i) ? a[4 * g + q] : 0.f;
                    *(LAS u32x2*)(SC + i * 72 + j0) = (u32x2){cvt_pk_bf16(e[0], e[1]), cvt_pk_bf16(e[2], e[3])}; }
            } else if (w == 3) {
#pragma unroll
                for (int g = 0; g < 4; ++g) *(LAS u32x2*)(SC + r * 72 + 32 + 8 * g + 4 * hh) = (u32x2){0u, 0u};
            }
            LBAR();
        }
        u32x2 gg[2][4];
        if (OUT) {
#pragma unroll
            for (int ib = 0; ib < 2; ++ib) { const int t = 32 * ib + r; const bf16_t* gp = zg + (size_t)(tok0 + (t < nvalid ? t : 0)) * 1024 + h * 256 + 32 * w + 4 * hh;
#pragma unroll
                for (int g = 0; g < 4; ++g) gg[ib][g] = *(const u32x2*)(gp + 8 * g); } }
        bf16x8 vf[4];
#pragma unroll
        for (int ks = 0; ks < 4; ++ks) vf[ks] = *(const LAS bf16x8*)(VT + (32 * w + r) * 72 + 16 * ks + 8 * hh);
        f32x16 oT[2];
        if (OUT) {
#pragma unroll
            for (int ib = 0; ib < 2; ++ib)
#pragma unroll
                for (int g = 0; g < 16; ++g) oT[ib][g] = 0.f;
#pragma unroll
            for (int db = 0; db < 4; ++db)
#pragma unroll
                for (int s = 0; s < 2; ++s) {
                    u32x4 ap; ap.x = cvt_pk_bf16(S[db][8 * s + 0], S[db][8 * s + 1]); ap.y = cvt_pk_bf16(S[db][8 * s + 2], S[db][8 * s + 3]);
                    ap.z = cvt_pk_bf16(S[db][8 * s + 4], S[db][8 * s + 5]); ap.w = cvt_pk_bf16(S[db][8 * s + 6], S[db][8 * s + 7]);
                    const bf16x8 A = __builtin_bit_cast(bf16x8, ap);
#pragma unroll
                    for (int ib = 0; ib < 2; ++ib) { const int i = 32 * ib + r;
                        const u32x2 lo = *(const LAS u32x2*)(QE + i * 136 + 32 * db + 16 * s + 4 * hh), hi = *(const LAS u32x2*)(QE + i * 136 + 32 * db + 16 * s + 8 + 4 * hh);
                        const u32x4 bp = (u32x4){lo.x, lo.y, hi.x, hi.y};
                        oT[ib] = MFMA32(A, __builtin_bit_cast(bf16x8, bp), oT[ib]); }
                    __builtin_amdgcn_sched_barrier(0); }
#pragma unroll
            for (int ks = 0; ks < 4; ++ks)
#pragma unroll
                for (int ib = 0; ib < 2; ++ib) { const bf16x8 B = *(const LAS bf16x8*)(SC + (32 * ib + r) * 72 + 16 * ks + 8 * hh); oT[ib] = MFMA32(vf[ks], B, oT[ib]); }
            __builtin_amdgcn_sched_barrier(0);
        }
#pragma unroll
        for (int db = 0; db < 4; ++db) {
#pragma unroll
            for (int g = 0; g < 4; ++g) { const f32x4 e = *(const LAS f32x4*)(EDEC + 32 * db + 8 * g + 4 * hh);
                S[db][4 * g + 0] *= e[0]; S[db][4 * g + 1] *= e[1]; S[db][4 * g + 2] *= e[2]; S[db][4 * g + 3] *= e[3]; }
#pragma unroll
            for (int ks = 0; ks < 4; ++ks) { const bf16x8 A = *(const LAS bf16x8*)(KLT + (32 * db + r) * 72 + 16 * ks + 8 * hh); S[db] = MFMA32(A, vf[ks], S[db]); }
            __builtin_amdgcn_sched_barrier(0);
        }
        if (OUT) { const int tnext = (ck + 1 < nchunks) ? tok0 + 64 : tok0; GLA_LOAD(tnext); }
        if (OUT) {
#pragma unroll
            for (int ib = 0; ib < 2; ++ib) { float ss = 0.f;
#pragma unroll
                for (int g = 0; g < 16; ++g) ss += oT[ib][g] * oT[ib][g];
                ss += __shfl_xor(ss, 32);
                if (hh == 0) PART[w * 64 + 32 * ib + r] = ss; }
            LBAR();
#pragma unroll
            for (int ib = 0; ib < 2; ++ib) { const int t = 32 * ib + r; float tot = 0.f;
#pragma unroll
                for (int q = 0; q < 8; ++q) tot += PART[q * 64 + t];
                const float rstd = rsqrtf(tot * (1.0f / 256.0f) + EPS);
                if (t < nvalid) { bf16_t* gp = zg + (size_t)(tok0 + t) * 1024 + h * 256 + 32 * w + 4 * hh;
#pragma unroll
                    for (int g = 0; g < 4; ++g) { const f32x4 gn = *(const LAS f32x4*)(GN + 32 * w + 8 * g + 4 * hh);
                        const float g0 = bf_lo(gg[ib][g].x), g1 = bf_hi(gg[ib][g].x), g2 = bf_lo(gg[ib][g].y), g3 = bf_hi(gg[ib][g].y);
                        const float o0 = oT[ib][4 * g + 0] * rstd * gn[0] * g0 * __builtin_amdgcn_rcpf(1.0f + __expf(-g0));
                        const float o1 = oT[ib][4 * g + 1] * rstd * gn[1] * g1 * __builtin_amdgcn_rcpf(1.0f + __expf(-g1));
                        const float o2 = oT[ib][4 * g + 2] * rstd * gn[2] * g2 * __builtin_amdgcn_rcpf(1.0f + __expf(-g2));
                        const float o3 = oT[ib][4 * g + 3] * rstd * gn[3] * g3 * __builtin_amdgcn_rcpf(1.0f + __expf(-g3));
                        *(u32x2*)(gp + 8 * g) = (u32x2){cvt_pk_bf16(o0, o1), cvt_pk_bf16(o2, o3)}; } } }
        }
        LBAR();
        if (PROBE_G && OUT && nvalid == 64 && blockIdx.x == 0 && tid == 0) gts[1] += (unsigned)__builtin_amdgcn_s_memrealtime() - g_t1;
    }
    if (Sfinal) { float* sp = Sfinal + (size_t)(4 * hh) * 256 + 32 * w + r;
#pragma unroll
        for (int db = 0; db < 4; ++db)
#pragma unroll
            for (int q4 = 0; q4 < 4; ++q4) { float* p = sp + (size_t)(32 * db + 8 * q4) * 256; asm volatile("" : "+v"(p));
                p[0] = S[db][4 * q4 + 0]; p[256] = S[db][4 * q4 + 1]; p[512] = S[db][4 * q4 + 2]; p[768] = S[db][4 * q4 + 3]; } }
    if (Dout && tq == 0) Dout[d] = __expf(dsum);
}


#undef GLA_LOAD
#undef GLA_LOADK
__device__ __forceinline__ f32x4 small_tile(LAS unsigned char* lds, const bf16_t* A, const bf16_t* Bt, int K, int row0, int col0) {
    const int tid = opaque_tid(), lane = tid & 63, w = __builtin_amdgcn_readfirstlane(tid >> 6), r = lane & 31, hh = lane >> 5;
    const int ksl = K >> 3;
    const bf16_t* ap = A + (size_t)(row0 + r) * K + w * ksl + 8 * hh;
    const bf16_t* b0 = Bt + (size_t)(col0 + r) * K + w * ksl + 8 * hh; const bf16_t* b1 = b0 + (size_t)32 * K;
    f32x16 c0, c1;
#pragma unroll
    for (int g = 0; g < 16; ++g) { c0[g] = 0.f; c1[g] = 0.f; }
    const int nks = ksl >> 4;
#pragma unroll 2
    for (int ks = 0; ks < nks; ++ks) { const bf16x8 a = *(const bf16x8*)(ap + 16 * ks), x = *(const bf16x8*)(b0 + 16 * ks), y = *(const bf16x8*)(b1 + 16 * ks);
        c0 = MFMA32(a, x, c0); c1 = MFMA32(a, y, c1); }
    LAS float* RED = (LAS float*)lds;
#pragma unroll
    for (int g = 0; g < 16; ++g) { const int row = (g & 3) + 8 * (g >> 2) + 4 * hh; RED[(w * 32 + row) * 64 + r] = c0[g]; RED[(w * 32 + row) * 64 + 32 + r] = c1[g]; }
    __syncthreads();
    const int row = tid >> 4, c4 = (tid & 15) * 4; f32x4 sum = (f32x4){0.f, 0.f, 0.f, 0.f};
#pragma unroll
    for (int q = 0; q < 8; ++q) sum += *(const LAS f32x4*)(RED + (q * 32 + row) * 64 + c4);
    __syncthreads();
    return sum;
}

#define XB_TMO      128
#define XB_XCNT(j)  (256  + 64 * (j))
#define XB_XSUB(j)  (1280 + 64 * (j))
#define XB_XGEN(j)  (2304 + 64 * (j))
#define XB_TOP      3328
#define XB_TOPGEN   3392
#define XCD_BAR_WORDS 3456
#define XB_SPIN_CAP (1u << 22)
__device__ __forceinline__ unsigned xb_ld(unsigned* p)              { return __hip_atomic_load(p, __ATOMIC_RELAXED, __HIP_MEMORY_SCOPE_AGENT); }
__device__ __forceinline__ unsigned xb_add(unsigned* p, unsigned v) { return __hip_atomic_fetch_add(p, v, __ATOMIC_RELAXED, __HIP_MEMORY_SCOPE_AGENT); }
__device__ __forceinline__ unsigned xb_xcc_id() { return (unsigned)__builtin_amdgcn_s_getreg((3 << 11) | 20) & 0xFu; }
#define XB_SPIN(cond, bar) do { unsigned _sp = 0; while (cond) { __builtin_amdgcn_s_sleep(1); \
    if ((++_sp & 255u) == 0u) { if (xb_ld(&(bar)[XB_TMO])) break; if (_sp > XB_SPIN_CAP) { atomicAdd(&(bar)[XB_TMO], 1u); break; } } } } while (0)
struct XcdBarrier { unsigned* bar; unsigned x; volatile LAS unsigned* st; };
__device__ __forceinline__ XcdBarrier xcd_barrier_post(unsigned* bar, volatile LAS unsigned* st) {
    XcdBarrier b; b.bar = bar; b.x = xb_xcc_id(); b.st = st;
    if (threadIdx.x == 0) (void)xb_add(&bar[XB_XCNT(b.x)], 1u);
    return b;
}
__device__ __forceinline__ void xcd_barrier_complete(unsigned* bar, unsigned x, unsigned& nloc, unsigned& nx) {
    const unsigned G = gridDim.x * gridDim.y * gridDim.z;
    unsigned sum, cnt, mine, sp = 0u;
    for (;;) {
        sum = 0u; cnt = 0u; mine = 0u;
#pragma unroll
        for (unsigned j = 0; j < 16; ++j) { const unsigned c = xb_ld(&bar[XB_XCNT(j)]); sum += c; cnt += (c > 0u) ? 1u : 0u; mine = (j == x) ? c : mine; }
        if (sum == G) break;
        __builtin_amdgcn_s_sleep(1);
        if ((++sp & 255u) == 0u) { if (xb_ld(&bar[XB_TMO])) break; if (sp > XB_SPIN_CAP) { atomicAdd(&bar[XB_TMO], 1u); break; } }
    }
    nloc = mine > 0u ? mine : 1u; nx = cnt > 0u ? cnt : 1u;
}
__device__ __forceinline__ void xcd_barrier(const XcdBarrier& b) {
    asm volatile("s_waitcnt vmcnt(0)" ::: "memory");
    __syncthreads();
    if (threadIdx.x == 0) {
        unsigned* bar = b.bar;
        __builtin_amdgcn_s_waitcnt(0);
        unsigned nloc = b.st[0], nx = b.st[1];
        if (nloc == 0u) { xcd_barrier_complete(bar, b.x, nloc, nx); b.st[0] = nloc; b.st[1] = nx; }
        const unsigned old = xb_add(&bar[XB_XSUB(b.x)], 1u);
        const unsigned gen = old / nloc;
        if (old + 1u == (gen + 1u) * nloc) {
            __builtin_amdgcn_fence(__ATOMIC_RELEASE, "agent");
            asm volatile("s_waitcnt vmcnt(0)" ::: "memory");
            const unsigned og = xb_add(&bar[XB_TOP], 1u);
            const unsigned tg = og / nx;
            if (og + 1u == (tg + 1u) * nx) xb_add(&bar[XB_TOPGEN], 1u);
            else XB_SPIN(xb_ld(&bar[XB_TOPGEN]) == tg, bar);
            __builtin_amdgcn_fence(__ATOMIC_ACQUIRE, "agent");
            xb_add(&bar[XB_XGEN(b.x)], 1u);
            asm volatile("s_waitcnt vmcnt(0)" ::: "memory");
        } else {
            XB_SPIN(xb_ld(&bar[XB_XGEN(b.x)]) == gen, bar);
            __builtin_amdgcn_fence(__ATOMIC_ACQUIRE, "agent");
            asm volatile("s_waitcnt vmcnt(0)" ::: "memory");
        }
    }
    __syncthreads();
}

__device__ __forceinline__ void cnt_publish(unsigned* c) {
    asm volatile("s_waitcnt vmcnt(0)" ::: "memory"); __syncthreads();
    if (threadIdx.x == 0) { __builtin_amdgcn_fence(__ATOMIC_RELEASE, "agent"); asm volatile("s_waitcnt vmcnt(0)" ::: "memory"); (void)__hip_atomic_fetch_add(c, 1u, __ATOMIC_RELAXED, __HIP_MEMORY_SCOPE_AGENT); }
}
__device__ __forceinline__ void cnt_wait(unsigned* c, unsigned n) {
    if (threadIdx.x == 0) { unsigned sp = 0u;
        while (__hip_atomic_load(c, __ATOMIC_RELAXED, __HIP_MEMORY_SCOPE_AGENT) < n) { __builtin_amdgcn_s_sleep(2); if (++sp > (1u << 22)) break; }
        __builtin_amdgcn_fence(__ATOMIC_ACQUIRE, "agent"); asm volatile("s_waitcnt vmcnt(0)" ::: "memory"); }
    __syncthreads();
}
__device__ __forceinline__ void final_norm_row(float* x, const float* gamma, int row, int lane) {
    float* xp = x + (size_t)row * 1024; f32x4 v[4]; float ss = 0.f;
#pragma unroll
    for (int i = 0; i < 4; ++i) v[i] = *(const f32x4*)(xp + i * 256 + lane * 4);
#pragma unroll
    for (int i = 0; i < 4; ++i) ss += v[i][0] * v[i][0] + v[i][1] * v[i][1] + v[i][2] * v[i][2] + v[i][3] * v[i][3];
#pragma unroll
    for (int o = 32; o >= 1; o >>= 1) ss += __shfl_xor(ss, o);
    const float rstd = rsqrtf(ss * (1.0f / 1024.0f) + EPS);
#pragma unroll
    for (int i = 0; i < 4; ++i) { const f32x4 g = *(const f32x4*)(gamma + i * 256 + lane * 4); *(f32x4*)(xp + i * 256 + lane * 4) = v[i] * rstd * g; }
}

__device__ __forceinline__ void norm_mod_row(const float* x, const float* gamma, const float* mod, int sh_off, int sc_off, bf16_t* H, int row, int lane) {
    const float* xp = x + (size_t)row * 1024; f32x4 v[4]; float ss = 0.f;
#pragma unroll
    for (int i = 0; i < 2; ++i) { v[2 * i] = *(const f32x4*)(xp + i * 512 + lane * 8); v[2 * i + 1] = *(const f32x4*)(xp + i * 512 + lane * 8 + 4); }
#pragma unroll
    for (int i = 0; i < 4; ++i) ss += v[i][0] * v[i][0] + v[i][1] * v[i][1] + v[i][2] * v[i][2] + v[i][3] * v[i][3];
#pragma unroll
    for (int o = 32; o >= 1; o >>= 1) ss += __shfl_xor(ss, o);
    const float rstd = rsqrtf(ss * (1.0f / 1024.0f) + EPS);
    const float* mp = mod + (size_t)modrow_of(row) * NMOD;
#pragma unroll
    for (int i = 0; i < 2; ++i) { const int c = i * 512 + lane * 8; float o[8];
#pragma unroll
        for (int hlf = 0; hlf < 2; ++hlf) { const f32x4 g = *(const f32x4*)(gamma + c + 4 * hlf), sc = *(const f32x4*)(mp + sc_off + c + 4 * hlf), sh = *(const f32x4*)(mp + sh_off + c + 4 * hlf);
#pragma unroll
            for (int j = 0; j < 4; ++j) o[4 * hlf + j] = v[2 * i + hlf][j] * rstd * g[j] * (1.0f + sc[j]) + sh[j]; }
        u32x4 w; w.x = cvt_pk_bf16(o[0], o[1]); w.y = cvt_pk_bf16(o[2], o[3]); w.z = cvt_pk_bf16(o[4], o[5]); w.w = cvt_pk_bf16(o[6], o[7]);
        *(u32x4*)(H + (size_t)row * 1024 + c) = w; }
}

__global__ void __launch_bounds__(512, 2) fwd_megakernel(Params P) {
    extern __shared__ __attribute__((aligned(16))) unsigned char lds_raw[];
    LAS unsigned char* lds = (LAS unsigned char*)lds_raw;
    cg::grid_group grid = cg::this_grid();
    const int G = gridDim.x, bid = blockIdx.x, tid = threadIdx.x;
    unsigned char* ws = P.ws;
    float* mod = (float*)(ws + WS_MOD);
    bf16_t* Hb = (bf16_t*)(ws + WS_H);
    bf16_t* Rg = (bf16_t*)P.out;
    bf16_t* Gg = Rg + (size_t)MTOT * 1024;
    volatile LAS unsigned* xst = (volatile LAS unsigned*)(lds + LDS_BYTES - 16);
    if (tid < 4) xst[tid] = 0u;
    if (tid < 32) ((volatile LAS unsigned*)(lds + LDS_BYTES - 128))[tid] = 0u;
    __syncthreads();
    const XcdBarrier xbar = xcd_barrier_post((unsigned*)(ws + WS_BAR), xst);
    if (P.ws == nullptr) grid.sync();
#ifndef PROBE_T
#define PROBE_T -1
#endif
#ifndef PROBE_T2
#define PROBE_T2 (PROBE_T + 1)
#endif
    volatile LAS unsigned* tsL = (volatile LAS unsigned*)(lds + LDS_BYTES - 128);
    int nts = 0;
#define STAMP() do { if (PROBE_T >= 0) { if (bid == 0 && tid == 0) tsL[nts] = (unsigned)__builtin_amdgcn_s_memrealtime(); ++nts; } } while (0)
#define GRID_SYNC() do { xcd_barrier(xbar); STAMP(); } while (0)
    STAMP();

#ifndef PHMASK
#define PHMASK 0xffff
#endif
#define PH(n) if ((PHMASK >> (n)) & 1)
    PH(0) phase0(P, lds);
    if (PROBE_P0) { __syncthreads(); phase0(P, lds); }
    for (int q = 0; q < PROBE_SYNC; ++q) GRID_SYNC();
    GRID_SYNC();
    PH(1) phase_norm_mod(P.in[0], P.in[1], P.in[8], mod, 0, 1024, Hb);
    if (PROBE_NORM) phase_norm_mod(P.in[0], P.in[1], P.in[8], mod, 0, 1024, Hb);
    GRID_SYNC();
    PH(2) { pg8::Gemm g{Hb, (const bf16_t*)(ws + WS_WIN), 1024}; pg8::Order S; S.init(66, 33, G, bid, 0, 0, 0, WGM_BIG);
      EpiIn E{ws, Rg, Gg}; pg8::gemm_phase<EpiIn>(lds, g, S, E); if (PROBE_DUP) pg8::gemm_phase<EpiIn>(lds, g, S, E); }
    GRID_SYNC();
    if (PROBE_GLA1) for (int it = bid; it < 240; it += G) { const int bh = it / 15, seg = it % 15, b = bh >> 2, h = bh & 3;
            gla_walk<false>(P, lds, h, b * 4096 + seg * (SEGCH * 64), SEGCH, 64, nullptr, (float*)(ws + SEG_STATE) + (size_t)(bh * 16 + seg) * 32768, (float*)(ws + SEG_DEC) + (size_t)(bh * 16 + seg) * 128); }
    PH(3) for (int it = bid; it < 304; it += G) {
        if (it < 240) { const int bh = it / 15, seg = it % 15, b = bh >> 2, h = bh & 3;
            gla_walk<false>(P, lds, h, b * 4096 + seg * (SEGCH * 64), SEGCH, 64, nullptr, (float*)(ws + SEG_STATE) + (size_t)(bh * 16 + seg) * 32768, (float*)(ws + SEG_DEC) + (size_t)(bh * 16 + seg) * 128);
        } else { const int sbh = it - 240, sb = sbh >> 2, h = sbh & 3;
            gla_walk<true>(P, lds, h, MP + sb * 32, 1, 32, P.in[4] + (size_t)sbh * 32768, P.out + O_SS + (size_t)sbh * 32768, nullptr); }
    }
    PH(4) { if (G == 256) { if (bid >= 48) for (int blk = bid - 48; blk < 264; blk += 208) conv_block(P, blk); }
            else for (int blk = bid; blk < 264; blk += G) conv_block(P, blk); }
    GRID_SYNC();
    for (int e4 = bid * 512 + tid; e4 < 16 * 8192; e4 += G * 512) { const int bh = e4 >> 13, idx = (e4 & 8191) * 4, dd = idx >> 8;
        float* lp = (float*)(ws + SEG_STATE) + (size_t)(bh * 16) * 32768 + idx; const float* dp = (const float*)(ws + SEG_DEC) + (bh * 16) * 128 + dd;
        f32x4 L[15]; float dc[15];
#pragma unroll
        for (int seg = 0; seg < 15; ++seg) { L[seg] = *(const f32x4*)(lp + (size_t)seg * 32768); dc[seg] = dp[seg * 128]; }
        f32x4 s = (f32x4){0.f, 0.f, 0.f, 0.f};
#pragma unroll
        for (int seg = 0; seg < 15; ++seg) { s = s * dc[seg] + L[seg]; *(f32x4*)(lp + (size_t)seg * 32768) = s; } }
    GRID_SYNC();
    PH(5) for (int it = bid; it < 256; it += G) { const int bh = it >> 4, seg = it & 15, b = bh >> 2, h = bh & 3;
        gla_walk<true>(P, lds, h, b * 4096 + seg * (SEGCH * 64), SEGCH, 64, seg ? (const float*)(ws + SEG_STATE) + (size_t)(bh * 16 + seg - 1) * 32768 : nullptr,
                       seg == 15 ? P.out + O_SP + (size_t)bh * 32768 : nullptr, nullptr); }
    GRID_SYNC();
    PH(6) { pg8::Gemm g{(const bf16_t*)(ws + Z_G), (const bf16_t*)(ws + WS_WGC), 1024}; pg8::Order S; S.init(64, 4, G, bid, 1, 66, 4);
      const bool small_first = (bid & 1) != 0;
      if (small_first) {
      for (int tl = bid; tl < 256; tl += G) { const int row0 = MP + (tl >> 4) * 32, col0 = (tl & 15) * 64;
          const f32x4 ya = small_tile(lds, (const bf16_t*)(ws + Z_G), (const bf16_t*)(ws + WS_WGC), 1024, row0, col0);
          const f32x4 yb = small_tile(lds, (const bf16_t*)(ws + Z_CB), (const bf16_t*)(ws + WS_WGC) + (size_t)1024 * 1024, 1024, row0, col0);
          const size_t o = (size_t)(row0 + (tid >> 4)) * 1024 + col0 + (tid & 15) * 4;
          const u32x2 rr = *(const u32x2*)(Rg + o), gg = *(const u32x2*)(Gg + o);
          const float m0 = bf_lo(gg.x) * (bf_lo(rr.x) * ya[0] + yb[0]), m1 = bf_hi(gg.x) * (bf_hi(rr.x) * ya[1] + yb[1]);
          const float m2 = bf_lo(gg.y) * (bf_lo(rr.y) * ya[2] + yb[2]), m3 = bf_hi(gg.y) * (bf_hi(rr.y) * ya[3] + yb[3]);
          *(u32x2*)((bf16_t*)(ws + Z_V) + o) = (u32x2){cvt_pk_bf16(m0, m1), cvt_pk_bf16(m2, m3)}; }
      }
      EpiMerge E{Rg, Gg, (bf16_t*)(ws + Z_V)}; pg8::gemm_phase<EpiMerge>(lds, g, S, E); if (PROBE_DUP) pg8::gemm_phase<EpiMerge>(lds, g, S, E);
      if (!small_first) {
      for (int tl = bid; tl < 256; tl += G) { const int row0 = MP + (tl >> 4) * 32, col0 = (tl & 15) * 64;
          const f32x4 ya = small_tile(lds, (const bf16_t*)(ws + Z_G), (const bf16_t*)(ws + WS_WGC), 1024, row0, col0);
          const f32x4 yb = small_tile(lds, (const bf16_t*)(ws + Z_CB), (const bf16_t*)(ws + WS_WGC) + (size_t)1024 * 1024, 1024, row0, col0);
          const size_t o = (size_t)(row0 + (tid >> 4)) * 1024 + col0 + (tid & 15) * 4;
          const u32x2 rr = *(const u32x2*)(Rg + o), gg = *(const u32x2*)(Gg + o);
          const float m0 = bf_lo(gg.x) * (bf_lo(rr.x) * ya[0] + yb[0]), m1 = bf_hi(gg.x) * (bf_hi(rr.x) * ya[1] + yb[1]);
          const float m2 = bf_lo(gg.y) * (bf_lo(rr.y) * ya[2] + yb[2]), m3 = bf_hi(gg.y) * (bf_hi(rr.y) * ya[3] + yb[3]);
          *(u32x2*)((bf16_t*)(ws + Z_V) + o) = (u32x2){cvt_pk_bf16(m0, m1), cvt_pk_bf16(m2, m3)}; }
      } }
    GRID_SYNC();
    if (G == 256) {
        pg8::Gemm g{(const bf16_t*)(ws + Z_V), (const bf16_t*)(ws + WS_WO), 1024}; pg8::Order S; S.init(64, 4, G, bid);
        unsigned* cnt = (unsigned*)(ws + WS_CNT) + 64 * 80; const int rbk = bid >> 4, cbk = bid & 15;
        const bool small_first = (bid & 1) != 0;
#define P5_SMALL() do { const int row0 = MP + rbk * 32, col0 = cbk * 64; \
            const f32x4 a = small_tile(lds, (const bf16_t*)(ws + Z_V), (const bf16_t*)(ws + WS_WO), 1024, row0, col0); \
            const int row = row0 + (tid >> 4), col = col0 + (tid & 15) * 4; \
            const f32x4 xb = *(const f32x4*)(P.in[1] + (size_t)(row - MP) * 1024 + col), gt = *(const f32x4*)(mod + 2048 + (size_t)modrow_of(row) * NMOD + col); \
            *(f32x4*)(P.out + (size_t)row * 1024 + col) = xb + gt * a; cnt_publish(cnt + 64 * (64 + rbk)); } while (0)
        if (small_first) P5_SMALL();
        { EpiResNormMod E{P.in[0], P.out, Hb, mod, P.in[18], (float*)(ws + WS_RSS2), cnt}; pg8::gemm_phase<EpiResNormMod>(lds, g, S, E); }
        if (!small_first) P5_SMALL();
#undef P5_SMALL
        cnt_wait(cnt + 64 * (64 + rbk), 16u);
        { const int t_ = opaque_tid(), lane = t_ & 63, wid = t_ >> 6; if (wid < 2) norm_mod_row(P.out, P.in[18], mod, 3072, 4096, Hb, MP + 32 * rbk + 2 * cbk + wid, lane); }
        GRID_SYNC();
    } else {
        PH(7) { pg8::Gemm g{(const bf16_t*)(ws + Z_V), (const bf16_t*)(ws + WS_WO), 1024}; pg8::Order S; S.init(64, 4, G, bid);
          const bool small_first = (bid & 1) != 0;
          if (small_first) {
          for (int tl = bid; tl < 256; tl += G) { const int row0 = MP + (tl >> 4) * 32, col0 = (tl & 15) * 64;
              const f32x4 a = small_tile(lds, (const bf16_t*)(ws + Z_V), (const bf16_t*)(ws + WS_WO), 1024, row0, col0);
              const int row = row0 + (tid >> 4), col = col0 + (tid & 15) * 4;
              const f32x4 xb = *(const f32x4*)(P.in[1] + (size_t)(row - MP) * 1024 + col), gt = *(const f32x4*)(mod + 2048 + (size_t)modrow_of(row) * NMOD + col);
              *(f32x4*)(P.out + (size_t)row * 1024 + col) = xb + gt * a; }
          }
          EpiRes E{P.in[0], P.in[1], P.out, mod + 2048}; pg8::gemm_phase<EpiRes>(lds, g, S, E); if (PROBE_DUP) pg8::gemm_phase<EpiRes>(lds, g, S, E);
          if (!small_first) {
          for (int tl = bid; tl < 256; tl += G) { const int row0 = MP + (tl >> 4) * 32, col0 = (tl & 15) * 64;
              const f32x4 a = small_tile(lds, (const bf16_t*)(ws + Z_V), (const bf16_t*)(ws + WS_WO), 1024, row0, col0);
              const int row = row0 + (tid >> 4), col = col0 + (tid & 15) * 4;
              const f32x4 xb = *(const f32x4*)(P.in[1] + (size_t)(row - MP) * 1024 + col), gt = *(const f32x4*)(mod + 2048 + (size_t)modrow_of(row) * NMOD + col);
              *(f32x4*)(P.out + (size_t)row * 1024 + col) = xb + gt * a; }
          } }
        GRID_SYNC();
        PH(8) phase_norm_mod(P.out, P.out + (size_t)MP * 1024, P.in[18], mod, 3072, 4096, Hb);
        GRID_SYNC();
    }
    PH(9) { pg8::Gemm g{Hb, (const bf16_t*)(ws + WS_WF1), 1024}; pg8::Order S; S.init(66, 22, G, bid, 0, 0, 0, WGM_BIG);
      EpiAct E{(bf16_t*)(ws + WS_Z)}; pg8::gemm_phase<EpiAct>(lds, g, S, E); if (PROBE_DUP) pg8::gemm_phase<EpiAct>(lds, g, S, E); }
    GRID_SYNC();
    if (G == 256) {
        pg8::Gemm g{(const bf16_t*)(ws + WS_Z), (const bf16_t*)(ws + WS_WF2), DFF}; pg8::Order S; S.init(64, 4, G, bid);
        unsigned* cnt = (unsigned*)(ws + WS_CNT); const int rbk = bid >> 4, cbk = bid & 15;
        const bool small_first = (bid & 1) != 0;
#define P8_SMALL() do { const int row0 = MP + rbk * 32, col0 = cbk * 64; \
            const f32x4 a = small_tile(lds, (const bf16_t*)(ws + WS_Z), (const bf16_t*)(ws + WS_WF2), DFF, row0, col0); \
            const int row = row0 + (tid >> 4), col = col0 + (tid & 15) * 4; float* op = P.out + (size_t)row * 1024 + col; \
            const f32x4 xb = *(const f32x4*)op, gt = *(const f32x4*)(mod + 5120 + (size_t)modrow_of(row) * NMOD + col); \
            *(f32x4*)op = xb + gt * a; cnt_publish(cnt + 64 * (64 + rbk)); } while (0)
        if (small_first) P8_SMALL();
        { EpiResNorm E{P.out, P.out, mod + 5120, P.in[21], (float*)(ws + WS_RSS), cnt}; pg8::gemm_phase<EpiResNorm>(lds, g, S, E); }
        if (!small_first) P8_SMALL();
#undef P8_SMALL
        cnt_wait(cnt + 64 * (64 + rbk), 16u);
        { const int t_ = opaque_tid(), lane = t_ & 63, wid = t_ >> 6; if (wid < 2) final_norm_row(P.out, P.in[21], MP + 32 * rbk + 2 * cbk + wid, lane); }
    } else {
        PH(10) { pg8::Gemm g{(const bf16_t*)(ws + WS_Z), (const bf16_t*)(ws + WS_WF2), DFF}; pg8::Order S; S.init(64, 4, G, bid);
          const bool small_first = (bid & 1) != 0;
          if (small_first) {
          for (int tl = bid; tl < 256; tl += G) { const int row0 = MP + (tl >> 4) * 32, col0 = (tl & 15) * 64;
              const f32x4 a = small_tile(lds, (const bf16_t*)(ws + WS_Z), (const bf16_t*)(ws + WS_WF2), DFF, row0, col0);
              const int row = row0 + (tid >> 4), col = col0 + (tid & 15) * 4;
              float* op = P.out + (size_t)row * 1024 + col;
              const f32x4 xb = *(const f32x4*)op, gt = *(const f32x4*)(mod + 5120 + (size_t)modrow_of(row) * NMOD + col);
              *(f32x4*)op = xb + gt * a; }
          }
          EpiRes E{P.out, P.out + (size_t)MP * 1024, P.out, mod + 5120}; pg8::gemm_phase<EpiRes>(lds, g, S, E);
          if (!small_first) {
          for (int tl = bid; tl < 256; tl += G) { const int row0 = MP + (tl >> 4) * 32, col0 = (tl & 15) * 64;
              const f32x4 a = small_tile(lds, (const bf16_t*)(ws + WS_Z), (const bf16_t*)(ws + WS_WF2), DFF, row0, col0);
              const int row = row0 + (tid >> 4), col = col0 + (tid & 15) * 4;
              float* op = P.out + (size_t)row * 1024 + col;
              const f32x4 xb = *(const f32x4*)op, gt = *(const f32x4*)(mod + 5120 + (size_t)modrow_of(row) * NMOD + col);
              *(f32x4*)op = xb + gt * a; }
          } }
        GRID_SYNC();
        PH(11) phase_final_norm(P.out, P.in[21]);
    }
    if (PROBE_T >= 0) { STAMP(); if (bid == 0 && tid == 0) { const unsigned dt = PROBE_G ? tsL[13 + PROBE_G] : tsL[PROBE_T2] - tsL[PROBE_T]; const unsigned t0 = (unsigned)__builtin_amdgcn_s_memrealtime();
        while ((unsigned)__builtin_amdgcn_s_memrealtime() - t0 < 8u * dt) __builtin_amdgcn_s_sleep(8); } }
}

extern "C" void kernel_launch(void* const* d_in, const int* in_sizes, int n_in, void* d_out, int out_size, void* d_ws, size_t ws_size, hipStream_t stream) {
    static int grid_blocks = 0;
    if (grid_blocks == 0) {
        if (n_in != 22 || ws_size < WS_END) { fprintf(stderr, "kernel_launch: unexpected n_in %d / ws %zu (need %zu)\n", n_in, ws_size, (size_t)WS_END); grid_blocks = -1; return; }
        int dev = 0, cus = 0, per_cu = 0;
        hipGetDevice(&dev); hipDeviceGetAttribute(&cus, hipDeviceAttributeMultiprocessorCount, dev);
        if (hipFuncSetAttribute((const void*)fwd_megakernel, hipFuncAttributeMaxDynamicSharedMemorySize, LDS_BYTES) != hipSuccess) { fprintf(stderr, "kernel_launch: hipFuncSetAttribute failed\n"); grid_blocks = -1; return; }
        hipOccupancyMaxActiveBlocksPerMultiprocessor(&per_cu, (const void*)fwd_megakernel, 512, LDS_BYTES);
        (void)hipGetLastError();
        if (per_cu < 1) per_cu = 1;
        grid_blocks = cus;
        fprintf(stderr, "kernel_launch: cus %d per_cu %d grid %d\n", cus, per_cu, grid_blocks);
    }
    if (grid_blocks < 0) return;
    if (hipMemsetAsync((char*)d_ws + WS_MOD, 0, (size_t)NMODROW * NMOD * 4, stream) != hipSuccess) { fprintf(stderr, "kernel_launch: memset failed\n"); return; }
    if (hipMemsetAsync((char*)d_ws + WS_BAR, 0, WS_END - WS_BAR, stream) != hipSuccess) { fprintf(stderr, "kernel_launch: memset failed\n"); return; }
    Params p{};
    for (int i = 0; i < 22; ++i) p.in[i] = (const float*)d_in[i];
    p.out = (float*)d_out; p.ws = (unsigned char*)d_ws;
    void* args[] = {&p};
    hipError_t e = hipLaunchCooperativeKernel((const void*)fwd_megakernel, dim3(grid_blocks), dim3(512), args, LDS_BYTES, stream);
    if (e != hipSuccess) fprintf(stderr, "cooperative launch failed: %s (grid %d)\n", hipGetErrorString(e), grid_blocks);
}
```
